# Optimizing an MI355X kernel written in HIP

```python
import math
import jax, jax.numpy as jnp
from jax import lax
import numpy as np

D_MODEL = 1024
BATCH = 8
SEQ = 2048
DEPTH = 2

CHUNK = 64
Q_BLOCK = 128
N_MIXERS = 2
SB_HEADS = 16
SB_HEAD_DIM = D_MODEL // SB_HEADS
DIFF_HEADS = 8
DIFF_QK_DIM = D_MODEL // (2 * DIFF_HEADS)
DIFF_V_DIM = 2 * DIFF_QK_DIM
D_FF = 2816
ROPE_THETA = 10000.0
RMS_EPS = 1e-6
N_SB = (DEPTH + 1) // 2
N_DIFF = DEPTH // 2

kernel_name = "hybrid_stickbreak_diffattn_macaron"


def _rms_norm(x, g):
    xf = x.astype(jnp.float32)
    y = xf * lax.rsqrt(jnp.mean(xf * xf, axis=-1, keepdims=True) + RMS_EPS)
    return (y * g.astype(jnp.float32)).astype(x.dtype)


def _swiglu_ffn(h, w_in, w_out):
    gu = h @ w_in
    g, u = jnp.split(gu, 2, axis=-1)
    return (jax.nn.silu(g) * u) @ w_out


def _rope(x, pos):
    d = x.shape[-1]
    half = d // 2
    inv_freq = ROPE_THETA ** (-jnp.arange(half, dtype=jnp.float32) / half)
    ang = pos.astype(jnp.float32)[:, None] * inv_freq[None, :]
    cos, sin = jnp.cos(ang), jnp.sin(ang)
    xf = x.astype(jnp.float32)
    x1, x2 = xf[..., :half], xf[..., half:]
    out = jnp.concatenate([x1 * cos - x2 * sin, x2 * cos + x1 * sin], axis=-1)
    return out.astype(x.dtype)


def _stick_breaking_mixer(h, w_qkv, w_o):
    B, S, D = h.shape
    qkv = (h @ w_qkv).reshape(B, S, 3, SB_HEADS, SB_HEAD_DIM)
    qkv = jnp.transpose(qkv, (2, 0, 3, 1, 4))
    q, k, v = qkv[0], qkv[1], qkv[2]
    scale = 1.0 / math.sqrt(SB_HEAD_DIM)
    outs = []
    for blk in range(S // Q_BLOCK):
        q0 = blk * Q_BLOCK
        kend = q0 + Q_BLOCK
        qb = q[:, :, q0:kend]
        kb, vb = k[:, :, :kend], v[:, :, :kend]
        z = jnp.einsum('bhqd,bhkd->bhqk', qb, kb).astype(jnp.float32) * scale
        qpos = q0 + jnp.arange(Q_BLOCK)
        kpos = jnp.arange(kend)
        strict = kpos[None, :] < qpos[:, None]
        log_1m = jnp.where(strict, -jax.nn.softplus(z), 0.0)
        suffix = lax.cumsum(log_1m, axis=3, reverse=True) - log_1m
        log_a = jax.nn.log_sigmoid(z) + suffix
        a = jnp.where(strict, jnp.exp(log_a), 0.0)
        outs.append(jnp.einsum('bhqk,bhkd->bhqd', a, vb.astype(jnp.float32)))
    o = jnp.concatenate(outs, axis=2).astype(h.dtype)
    o = jnp.transpose(o, (0, 2, 1, 3)).reshape(B, S, D)
    return o @ w_o


def _diff_attention_mixer(h, w_qkv, w_o, lam_params, subln_g, layer_idx):
    B, S, D = h.shape
    lambda_init = 0.8 - 0.6 * math.exp(-0.3 * (layer_idx - 1))
    qk_w = DIFF_HEADS * 2 * DIFF_QK_DIM
    proj = h @ w_qkv
    q = proj[..., :qk_w].reshape(B, S, DIFF_HEADS, 2, DIFF_QK_DIM)
    k = proj[..., qk_w:2 * qk_w].reshape(B, S, DIFF_HEADS, 2, DIFF_QK_DIM)
    v = proj[..., 2 * qk_w:].reshape(B, S, DIFF_HEADS, DIFF_V_DIM)
    q = jnp.transpose(q, (3, 0, 2, 1, 4))
    k = jnp.transpose(k, (3, 0, 2, 1, 4))
    v = jnp.transpose(v, (0, 2, 1, 3))
    pos = jnp.arange(S)
    q1, q2 = _rope(q[0], pos), _rope(q[1], pos)
    k1, k2 = _rope(k[0], pos), _rope(k[1], pos)
    lp = lam_params.astype(jnp.float32)
    lam = jnp.exp(jnp.sum(lp[0] * lp[1])) - jnp.exp(jnp.sum(lp[2] * lp[3])) + lambda_init
    scale = 1.0 / math.sqrt(DIFF_QK_DIM)
    outs = []
    for blk in range(S // Q_BLOCK):
        q0 = blk * Q_BLOCK
        kend = q0 + Q_BLOCK
        qpos = q0 + jnp.arange(Q_BLOCK)
        kpos = jnp.arange(kend)
        mask = (kpos[None, :] // CHUNK) <= (qpos[:, None] // CHUNK)
        s1 = jnp.einsum('bhqd,bhkd->bhqk', q1[:, :, q0:kend], k1[:, :, :kend]).astype(jnp.float32) * scale
        s2 = jnp.einsum('bhqd,bhkd->bhqk', q2[:, :, q0:kend], k2[:, :, :kend]).astype(jnp.float32) * scale
        a1 = jax.nn.softmax(jnp.where(mask, s1, -jnp.inf), axis=-1)
        a2 = jax.nn.softmax(jnp.where(mask, s2, -jnp.inf), axis=-1)
        a = a1 - lam * a2
        outs.append(jnp.einsum('bhqk,bhkd->bhqd', a, v[:, :, :kend].astype(jnp.float32)))
    o = jnp.concatenate(outs, axis=2)
    o = o * lax.rsqrt(jnp.mean(o * o, axis=-1, keepdims=True) + RMS_EPS)
    o = o * subln_g.astype(jnp.float32) * (1.0 - lambda_init)
    o = jnp.transpose(o.astype(h.dtype), (0, 2, 1, 3)).reshape(B, S, DIFF_HEADS * DIFF_V_DIM)
    return o @ w_o


def setup_inputs(seed: int = 0) -> dict:
    key = jax.random.key(seed)
    ks = jax.random.split(key, 12)
    D, F = D_MODEL, D_FF
    x = jax.random.normal(ks[0], (BATCH, SEQ, D), jnp.float32)
    norm_gains = 1.0 + 0.02 * jax.random.normal(ks[1], (DEPTH, 3, D), jnp.float32)
    final_gain = 1.0 + 0.02 * jax.random.normal(ks[2], (D,), jnp.float32)
    ffn_w_in = jax.random.normal(ks[3], (DEPTH, 2, D, 2 * F), jnp.float32) * D ** -0.5
    ffn_w_out = jax.random.normal(ks[4], (DEPTH, 2, F, D), jnp.float32) * F ** -0.5
    sb_w_qkv = jax.random.normal(ks[5], (N_SB, D, 3 * D), jnp.float32) * D ** -0.5
    sb_w_o = jax.random.normal(ks[6], (N_SB, D, D), jnp.float32) * D ** -0.5
    diff_w_qkv = jax.random.normal(ks[7], (N_DIFF, D, 3 * D), jnp.float32) * D ** -0.5
    diff_w_o = jax.random.normal(ks[8], (N_DIFF, DIFF_HEADS * DIFF_V_DIM, D), jnp.float32) * D ** -0.5
    diff_lambda = 0.1 * jax.random.normal(ks[9], (N_DIFF, 4, DIFF_QK_DIM), jnp.float32)
    diff_subln = 1.0 + 0.02 * jax.random.normal(ks[10], (N_DIFF, DIFF_V_DIM), jnp.float32)
    return {"x": x, "norm_gains": norm_gains, "final_gain": final_gain,
            "ffn_w_in": ffn_w_in, "ffn_w_out": ffn_w_out,
            "sb_w_qkv": sb_w_qkv, "sb_w_o": sb_w_o,
            "diff_w_qkv": diff_w_qkv, "diff_w_o": diff_w_o,
            "diff_lambda": diff_lambda, "diff_subln": diff_subln}


def reference(x, norm_gains, final_gain, ffn_w_in, ffn_w_out, sb_w_qkv, sb_w_o,
              diff_w_qkv, diff_w_o, diff_lambda, diff_subln):
    h = x
    for i in range(DEPTH):
        h = h + 0.5 * _swiglu_ffn(_rms_norm(h, norm_gains[i, 0]), ffn_w_in[i, 0], ffn_w_out[i, 0])
        hn = _rms_norm(h, norm_gains[i, 1])
        j = i // N_MIXERS
        if i % N_MIXERS == 0:
            mix = _stick_breaking_mixer(hn, sb_w_qkv[j], sb_w_o[j])
        else:
            mix = _diff_attention_mixer(hn, diff_w_qkv[j], diff_w_o[j], diff_lambda[j],
                                        diff_subln[j], i + 1)
        h = h + mix
        h = h + 0.5 * _swiglu_ffn(_rms_norm(h, norm_gains[i, 2]), ffn_w_in[i, 1], ffn_w_out[i, 1])
    return _rms_norm(h, final_gain)
```

```cpp
#include <hip/hip_runtime.h>
#include <hip/hip_cooperative_groups.h>
#include <cstdio>
#include <cstdint>
namespace cg = cooperative_groups;
namespace pg8 {
#define PG8_LAS __attribute__((address_space(3)))
typedef unsigned short bf16_t;
typedef short bf16x8 __attribute__((ext_vector_type(8)));
typedef float f32x4 __attribute__((ext_vector_type(4)));
typedef unsigned u32x4 __attribute__((ext_vector_type(4)));
constexpr int BM = 256, BK = 64, HALF = 128, HTB = HALF * BK * 2  , STAGE_BYTES = 8 * HTB, NXCD = 8, WGM = 8;

__host__ __device__ __forceinline__ int lds_byte(int r, int c) { const int st = (r >> 4) * 2 + (c >> 5), rr = r & 15, cc = c & 31, ob = rr * 64 + cc * 2; return st * 1024 + (ob ^ (((ob >> 9) & 1) << 5)); }
__host__ __device__ __forceinline__ void stage_rc(int b, int& R, int& C) { const int st = b / 1024, sb = b % 1024, swz = sb ^ (((sb >> 9) & 1) << 5); R = (st >> 1) * 16 + swz / 64; C = (st & 1) * 32 + (swz % 64) / 2; }
__host__ __device__ __forceinline__ int perm32(int rho) { const int n = rho >> 4, i = rho & 15; return 8 * (i >> 2) + 4 * n + (i & 3); }

struct Unit { int pm, pn; };
struct Gemm { const bf16_t* A; const bf16_t* Bt; int M, N, K; };

struct StaticOrder {
    int nM, nN, nwg, G, c;
    __host__ __device__ void init(int M, int N, int G_, int c_) { nM = M / BM; nN = N / BM; nwg = nM * nN; G = G_; c = c_; }
    __host__ __device__ bool next(int i, Unit& u) const {
        const long L = (long)i * G + c; if (L >= nwg) return false;
        int wgid = (int)L; { const int q = nwg / NXCD, r = nwg % NXCD, xcd = wgid % NXCD, off = wgid / NXCD; wgid = (xcd < r ? xcd * (q + 1) : r * (q + 1) + (xcd - r) * q) + off; }
        const int nig = WGM * nN, gid = wgid / nig, fm = gid * WGM, gsz = (nM - fm) < WGM ? (nM - fm) : WGM;
        u.pm = fm + ((wgid % nig) % gsz); u.pn = (wgid % nig) / gsz; return true;
    }
    __device__ __forceinline__ void a_ready(const Unit&) const {}
    __device__ __forceinline__ void done(const Unit&) const {}
};
__device__ __forceinline__ unsigned cvt_pk_bf16(float lo, float hi) { unsigned r; asm volatile("v_cvt_pk_bf16_f32 %0, %1, %2" : "=v"(r) : "v"(lo), "v"(hi)); return r; }
typedef float f32x2 __attribute__((ext_vector_type(2)));
__device__ __forceinline__ float rstd_of(float ssq) { return 1.0f / sqrtf(ssq * (1.0f / 1024.0f) + 1e-6f); }
struct EpiSwiglu {
    static constexpr bool PERM = true, AFTER_DRAIN = false;
    bf16_t* H; const float* ssq; int ldh;
    __device__ __forceinline__ void operator()(const f32x4 (&acc)[2][2][4][2], const Unit& u, int wr, int wc, int fr, int fq) const {
        const int row0 = u.pm * BM + wr * 64 + fr, hcol = u.pn * HALF + wc * 32 + 8 * fq;
#pragma unroll
        for (int ai = 0; ai < 2; ++ai)
#pragma unroll
            for (int m = 0; m < 4; ++m) { const int row = row0 + ai * HALF + m * 16; const float rs = rstd_of(ssq[row]);
                float hv[8];
#pragma unroll
                for (int n = 0; n < 2; ++n)
#pragma unroll
                    for (int e = 0; e < 4; ++e) { const float g = acc[ai][0][m][n][e] * rs, up = acc[ai][1][m][n][e] * rs;
                        const float ex = __builtin_amdgcn_exp2f(-g * 1.4426950408889634f);
                        hv[n * 4 + e] = g * up * __builtin_amdgcn_rcpf(1.0f + ex); }
                u32x4 w; w.x = cvt_pk_bf16(hv[0], hv[1]); w.y = cvt_pk_bf16(hv[2], hv[3]); w.z = cvt_pk_bf16(hv[4], hv[5]); w.w = cvt_pk_bf16(hv[6], hv[7]);
                *(u32x4*)(H + (size_t)row * ldh + hcol) = w; }
    }
};
struct EpiRes {
    static constexpr bool PERM = true, AFTER_DRAIN = false;
    const float* base; float* out; bf16_t* xa; const float* gain; float* ssq; float alpha;
    __device__ __forceinline__ void operator()(const f32x4 (&acc)[2][2][4][2], const Unit& u, int wr, int wc, int fr, int fq) const {
        const int row0 = u.pm * BM + wr * 64 + fr, col0 = u.pn * BM + wc * 32 + 8 * fq;
        f32x4 gv[2][2];
#pragma unroll
        for (int bj = 0; bj < 2; ++bj)
#pragma unroll
            for (int n = 0; n < 2; ++n) gv[bj][n] = *(const f32x4*)(gain + col0 + bj * HALF + 4 * n);
#pragma unroll
        for (int ai = 0; ai < 2; ++ai)
#pragma unroll
            for (int m = 0; m < 4; ++m) { const int row = row0 + ai * HALF + m * 16; float s = 0.f;
#pragma unroll
                for (int bj = 0; bj < 2; ++bj) { const size_t off = (size_t)row * 1024 + col0 + bj * HALF;
                    const f32x4 b0 = *(const f32x4*)(base + off), b1 = *(const f32x4*)(base + off + 4);
                    const f32x4 v0 = b0 + acc[ai][bj][m][0] * alpha, v1 = b1 + acc[ai][bj][m][1] * alpha;
                    *(f32x4*)(out + off) = v0; *(f32x4*)(out + off + 4) = v1;
                    s += (v0[0] * v0[0] + v0[1] * v0[1]) + (v0[2] * v0[2] + v0[3] * v0[3]) + (v1[0] * v1[0] + v1[1] * v1[1]) + (v1[2] * v1[2] + v1[3] * v1[3]);
                    const f32x4 a0 = v0 * gv[bj][0], a1 = v1 * gv[bj][1];
                    u32x4 w; w.x = cvt_pk_bf16(a0[0], a0[1]); w.y = cvt_pk_bf16(a0[2], a0[3]); w.z = cvt_pk_bf16(a1[0], a1[1]); w.w = cvt_pk_bf16(a1[2], a1[3]);
                    *(u32x4*)(xa + off) = w; }
                s += __shfl_xor(s, 16); s += __shfl_xor(s, 32);
                if (fq == 0) __hip_atomic_fetch_add(ssq + row, s, __ATOMIC_RELAXED, __HIP_MEMORY_SCOPE_AGENT); }
    }
};
struct EpiQKV {
    static constexpr bool PERM = true, AFTER_DRAIN = false;
    bf16_t* O; size_t stride; const float* ssq; float qscale; const float* rcos; const float* rsin;
    __device__ __forceinline__ void operator()(const f32x4 (&acc)[2][2][4][2], const Unit& u, int wr, int wc, int fr, int fq) const {
        const int t = u.pn >> 2, colt = (u.pn & 3) * BM;
        bf16_t* basep = O + (size_t)t * stride;
        const int row0 = u.pm * BM + wr * 64 + fr, col0 = colt + wc * 32 + 8 * fq;
        const float sc0 = (t == 0) ? qscale : 1.0f;
        const bool dorope = (rcos != nullptr) && (t < 2);
        const int pr0 = (wc & 1) * 16 + 4 * fq;
#pragma unroll
        for (int ai = 0; ai < 2; ++ai)
#pragma unroll
            for (int m = 0; m < 4; ++m) { const int row = row0 + ai * HALF + m * 16; const float sc = rstd_of(ssq[row]) * sc0;
                f32x4 cs = (f32x4){1.f, 1.f, 1.f, 1.f}, sn = (f32x4){0.f, 0.f, 0.f, 0.f};
                if (dorope) { const int pos = row & 2047; cs = *(const f32x4*)(rcos + pos * 32 + pr0); sn = *(const f32x4*)(rsin + pos * 32 + pr0); }
#pragma unroll
                for (int bj = 0; bj < 2; ++bj) { const f32x4 v0 = acc[ai][bj][m][0] * sc, v1 = acc[ai][bj][m][1] * sc;
                    float o[8];
                    o[0] = v0[0] * cs[0] - v0[1] * sn[0]; o[1] = v0[1] * cs[0] + v0[0] * sn[0];
                    o[2] = v0[2] * cs[1] - v0[3] * sn[1]; o[3] = v0[3] * cs[1] + v0[2] * sn[1];
                    o[4] = v1[0] * cs[2] - v1[1] * sn[2]; o[5] = v1[1] * cs[2] + v1[0] * sn[2];
                    o[6] = v1[2] * cs[3] - v1[3] * sn[3]; o[7] = v1[3] * cs[3] + v1[2] * sn[3];
                    u32x4 w; w.x = cvt_pk_bf16(o[0], o[1]); w.y = cvt_pk_bf16(o[2], o[3]); w.z = cvt_pk_bf16(o[4], o[5]); w.w = cvt_pk_bf16(o[6], o[7]);
                    *(u32x4*)(basep + (size_t)row * 1024 + col0 + bj * HALF) = w; } }
    }
};
template <class Epi, class Sched, bool ALIGN_EPI = false, bool SP2 = false>
__device__ __forceinline__ void gemm_phase(PG8_LAS unsigned char* lds, const Gemm g, const Sched& S, const Epi& E) {
    int tid_ = threadIdx.x; asm volatile("" : "+v"(tid_));
    const int tid = tid_, wid = __builtin_amdgcn_readfirstlane(tid >> 6), lane = tid & 63, wr = wid >> 2, wc = wid & 3, fr = lane & 15, fq = lane >> 4;
    const int K = g.K, nt = K / BK;
    unsigned voffA[2], voffB[2];
#pragma unroll
    for (int i = 0; i < 2; ++i) { int R, C; stage_rc(tid * 16 + i * 8192, R, C); const int Rb = Epi::PERM ? ((R & ~31) + perm32(R & 31)) : R;
        voffA[i] = (unsigned)(R * K + C) * 2u; voffB[i] = (unsigned)(Rb * K + C) * 2u; }
    const size_t kstep = (size_t)(BK * 2);
    const size_t hstep = (size_t)HALF * K * 2;
    const size_t tstep = 2 * hstep;
    const unsigned ldsw = (unsigned)wid * 1024u;
    const int aoff = lds_byte(wr * 64 + fr, fq * 8), boff = lds_byte(wc * 32 + fr, fq * 8);
#define PG8_SA(b, h) (((b) * 2 + (h)) * HTB)
#define PG8_SB(b, h) ((4 + (b) * 2 + (h)) * HTB)
#define PG8_STAGE(bufoff, gbase, voff) do { _Pragma("unroll") for (int _i = 0; _i < 2; ++_i) \
        __builtin_amdgcn_global_load_lds((const unsigned*)((const char*)(gbase) + (voff)[_i]), (PG8_LAS unsigned*)(lds + (bufoff) + ldsw + _i * 8192), 16, 0, 0); } while (0)
#define PG8_LDA(dst, b, h) do { _Pragma("unroll") for (int m = 0; m < 4; ++m) _Pragma("unroll") for (int k = 0; k < 2; ++k) dst[m][k] = *(const PG8_LAS bf16x8*)(lds + PG8_SA(b, h) + aoff + m * 2048 + k * 1024); } while (0)
#define PG8_LDB(dst, b, h) do { _Pragma("unroll") for (int n = 0; n < 2; ++n) _Pragma("unroll") for (int k = 0; k < 2; ++k) dst[n][k] = *(const PG8_LAS bf16x8*)(lds + PG8_SB(b, h) + boff + n * 2048 + k * 1024); } while (0)
#define PG8_MMA(ai, bj, At, Bt) do { __builtin_amdgcn_s_setprio(1); _Pragma("unroll") for (int m = 0; m < 4; ++m) _Pragma("unroll") for (int n = 0; n < 2; ++n) _Pragma("unroll") for (int k = 0; k < 2; ++k) \
        acc[ai][bj][m][n] = __builtin_amdgcn_mfma_f32_16x16x32_bf16(Bt[n][k], At[m][k], acc[ai][bj][m][n], 0, 0, 0); __builtin_amdgcn_s_setprio(0); } while (0)
#define PG8_WAIT_V(n) asm volatile("s_waitcnt vmcnt(" #n ")" ::: "memory")
#define PG8_WAIT_L(n) asm volatile("s_waitcnt lgkmcnt(" #n ")" ::: "memory")
#define PG8_BAR __builtin_amdgcn_s_barrier()
#define PG8_SCHED __builtin_amdgcn_sched_barrier(0)
    Unit cur, nxt; int ui = 0;
    if (!S.next(0, cur)) return;
    f32x4 acc[2][2][4][2];
#pragma unroll
    for (int a = 0; a < 2; ++a)
#pragma unroll
        for (int b = 0; b < 2; ++b)
#pragma unroll
            for (int m = 0; m < 4; ++m)
#pragma unroll
                for (int n = 0; n < 2; ++n) acc[a][b][m][n] = (f32x4){0.f, 0.f, 0.f, 0.f};
    bf16x8 At[4][2], B0[2][2], B1[2][2];
    const char* cA = (const char*)g.A + (size_t)cur.pm * tstep; const char* cB = (const char*)g.Bt + (size_t)cur.pn * tstep;
    S.a_ready(cur);
    if constexpr (SP2) {
        PG8_STAGE(PG8_SB(0, 0), cB, voffB); PG8_STAGE(PG8_SB(0, 1), cB + hstep, voffB); PG8_STAGE(PG8_SA(0, 0), cA, voffA); PG8_STAGE(PG8_SA(0, 1), cA + hstep, voffA);
        if (wr == 1) PG8_BAR;
        PG8_WAIT_V(2); PG8_BAR;
        PG8_STAGE(PG8_SB(1, 0), cB + kstep, voffB); PG8_STAGE(PG8_SA(1, 0), cA + kstep, voffA); PG8_STAGE(PG8_SB(1, 1), cB + hstep + kstep, voffB);
        PG8_WAIT_V(6); PG8_BAR;
    } else {
        PG8_STAGE(PG8_SB(0, 0), cB, voffB); PG8_STAGE(PG8_SA(0, 0), cA, voffA); PG8_STAGE(PG8_SB(0, 1), cB + hstep, voffB); PG8_STAGE(PG8_SA(0, 1), cA + hstep, voffA);
        if (wr == 1) PG8_BAR;
        PG8_WAIT_V(4); PG8_BAR;
        PG8_STAGE(PG8_SB(1, 0), cB + kstep, voffB); PG8_STAGE(PG8_SA(1, 0), cA + kstep, voffA); PG8_STAGE(PG8_SB(1, 1), cB + hstep + kstep, voffB);
        PG8_WAIT_V(6); PG8_BAR;
    }
    for (;;) {
        const bool has_next = S.next(ui + 1, nxt);
        const char* nA = has_next ? (const char*)g.A + (size_t)nxt.pm * tstep : cA; const char* nB = has_next ? (const char*)g.Bt + (size_t)nxt.pn * tstep : cB;
        for (int t = 0; t < nt; t += 2) {
            const bool last = (t == nt - 2);
            const char* a1 = cA + (size_t)(t + 1) * kstep;
            const char* a2 = last ? nA : cA + (size_t)(t + 2) * kstep; const char* b2 = last ? nB : cB + (size_t)(t + 2) * kstep;
            const char* a3 = a2 + kstep; const char* b3 = b2 + kstep;
            if (last && has_next) S.a_ready(nxt);
            if constexpr (SP2) {
            PG8_LDB(B0, 0, 0); PG8_LDB(B1, 0, 1); PG8_SCHED; PG8_LDA(At, 0, 0); PG8_STAGE(PG8_SA(1, 1), a1 + hstep, voffA);
            PG8_WAIT_V(8); PG8_WAIT_L(0); PG8_BAR; PG8_MMA(0, 0, At, B0); PG8_MMA(0, 1, At, B1); PG8_BAR; PG8_SCHED;
            PG8_LDA(At, 0, 1); PG8_STAGE(PG8_SB(0, 0), b2, voffB); PG8_STAGE(PG8_SB(0, 1), b2 + hstep, voffB); PG8_STAGE(PG8_SA(0, 0), a2, voffA);
            PG8_WAIT_V(8); PG8_WAIT_L(0); PG8_BAR; PG8_MMA(1, 0, At, B0); PG8_MMA(1, 1, At, B1); PG8_BAR; PG8_SCHED;
            PG8_LDB(B0, 1, 0); PG8_LDB(B1, 1, 1); PG8_SCHED; PG8_LDA(At, 1, 0); PG8_STAGE(PG8_SA(0, 1), a2 + hstep, voffA);
            PG8_WAIT_V(8); PG8_WAIT_L(0); PG8_BAR; PG8_MMA(0, 0, At, B0); PG8_MMA(0, 1, At, B1); PG8_BAR; PG8_SCHED;
            PG8_LDA(At, 1, 1); PG8_STAGE(PG8_SB(1, 0), b3, voffB); PG8_STAGE(PG8_SB(1, 1), b3 + hstep, voffB); PG8_STAGE(PG8_SA(1, 0), a3, voffA);
            PG8_WAIT_V(8); PG8_WAIT_L(0); PG8_BAR; PG8_MMA(1, 0, At, B0); PG8_MMA(1, 1, At, B1); PG8_BAR; PG8_SCHED;
            } else {
            PG8_LDB(B0, 0, 0); PG8_SCHED; PG8_LDA(At, 0, 0); PG8_STAGE(PG8_SA(1, 1), a1 + hstep, voffA);
            PG8_WAIT_L(8); PG8_BAR; PG8_WAIT_L(0); PG8_MMA(0, 0, At, B0); PG8_BAR; PG8_SCHED;
            PG8_LDB(B1, 0, 1); PG8_STAGE(PG8_SB(0, 0), b2, voffB);
            PG8_BAR; PG8_WAIT_L(0); PG8_MMA(0, 1, At, B1); PG8_BAR;
            PG8_LDA(At, 0, 1); PG8_STAGE(PG8_SA(0, 0), a2, voffA);
            PG8_BAR; PG8_WAIT_L(0); PG8_MMA(1, 0, At, B0); PG8_BAR; PG8_SCHED;
            PG8_STAGE(PG8_SB(0, 1), b2 + hstep, voffB);
            PG8_WAIT_V(6); PG8_BAR; PG8_MMA(1, 1, At, B1); PG8_BAR;
            PG8_LDB(B0, 1, 0); PG8_SCHED; PG8_LDA(At, 1, 0); PG8_STAGE(PG8_SA(0, 1), a2 + hstep, voffA);
            PG8_WAIT_L(8); PG8_BAR; PG8_WAIT_L(0); PG8_MMA(0, 0, At, B0); PG8_BAR; PG8_SCHED;
            PG8_LDB(B1, 1, 1); PG8_STAGE(PG8_SB(1, 0), b3, voffB);
            PG8_BAR; PG8_WAIT_L(0); PG8_MMA(0, 1, At, B1); PG8_BAR;
            PG8_LDA(At, 1, 1); PG8_STAGE(PG8_SA(1, 0), a3, voffA);
            PG8_BAR; PG8_WAIT_L(0); PG8_MMA(1, 0, At, B0); PG8_BAR; PG8_SCHED;
            PG8_STAGE(PG8_SB(1, 1), b3 + hstep, voffB);
            PG8_WAIT_V(6); PG8_BAR; PG8_MMA(1, 1, At, B1); PG8_BAR;
            }
        }
        if constexpr (ALIGN_EPI) { if (wr == 0) PG8_BAR; }
        if constexpr (!Epi::AFTER_DRAIN) { E(acc, cur, wr, wc, fr, fq); S.done(cur); }
        if (!has_next) break;
#pragma unroll
        for (int a = 0; a < 2; ++a)
#pragma unroll
            for (int b = 0; b < 2; ++b)
#pragma unroll
                for (int m = 0; m < 4; ++m)
#pragma unroll
                    for (int n = 0; n < 2; ++n) acc[a][b][m][n] = (f32x4){0.f, 0.f, 0.f, 0.f};
        cur = nxt; cA = nA; cB = nB; ++ui;
        if constexpr (ALIGN_EPI) { if (wr == 1) PG8_BAR; }
    }
    PG8_WAIT_V(0);
    if constexpr (!ALIGN_EPI) { if (wr == 0) PG8_BAR; }
    PG8_BAR;
    if constexpr (Epi::AFTER_DRAIN) { E.fused(acc, cur, wr, wc, fr, fq, lds, wid, lane); S.done(cur); }
#undef PG8_SA
#undef PG8_SB
#undef PG8_STAGE
#undef PG8_LDA
#undef PG8_LDB
#undef PG8_MMA
#undef PG8_WAIT_V
#undef PG8_WAIT_L
#undef PG8_BAR
#undef PG8_SCHED
}
}
constexpr int SEQ = 2048, NB = 8, DM = 1024, M = NB * SEQ, FF = 2816, NUP = 2 * FF, NQKV = 3 * DM;
constexpr float QSCALE = 0.125f * 1.4426950408889634f;
constexpr float LAMBDA_INIT = 0.35550906f;
constexpr size_t MiB = 1u << 20;
constexpr size_t WS_SSQ = 256 * 1024;
constexpr size_t WS_ROPE = 1 * MiB;
constexpr size_t WS_WIN = 2 * MiB;
constexpr size_t WS_WOUT = 46 * MiB;
constexpr size_t WS_WQKV = 68 * MiB;
constexpr size_t WS_WO = 80 * MiB;
constexpr size_t WS_XA = 84 * MiB;
constexpr size_t WS_H = 116 * MiB;
constexpr size_t WS_Q = 116 * MiB, WS_K = 148 * MiB, WS_V = 180 * MiB;
constexpr size_t WS_O = 212 * MiB;
constexpr size_t WS_T = 244 * MiB;
constexpr size_t WS_END = 308 * MiB;
constexpr int LDS_BYTES = 147456;
constexpr int NPHASE = 16;

#define GAS __attribute__((address_space(1)))
#define LAS __attribute__((address_space(3)))
typedef unsigned short bf16;
typedef unsigned v4u __attribute__((ext_vector_type(4)));
typedef float f32x4 __attribute__((ext_vector_type(4)));
__device__ __forceinline__ unsigned f2bf(float f) { unsigned u = __builtin_bit_cast(unsigned, f); return (u + 0x7fffu + ((u >> 16) & 1u)) >> 16; }
__device__ __forceinline__ unsigned pk2(float lo, float hi) { return f2bf(lo) | (f2bf(hi) << 16); }
__device__ __forceinline__ float bflo(unsigned u) { return __uint_as_float(u << 16); }
__device__ __forceinline__ float bfhi(unsigned u) { return __uint_as_float(u & 0xffff0000u); }
__device__ __forceinline__ int tid_opaque() { int t = threadIdx.x; asm volatile("" : "+v"(t)); return t; }
__device__ __forceinline__ int bid_opaque() { int t = blockIdx.x; asm volatile("" : "+s"(t)); return t; }
__device__ __forceinline__ float wave_sum(float v) {
#pragma unroll
    for (int o = 1; o < 64; o <<= 1) v += __shfl_xor(v, o);
    return v;
}

struct Args { const float* x; const float* ng; const float* fg; const float* w_in; const float* w_out; const float* sb_qkv; const float* sb_o;
              const float* df_qkv; const float* df_o; const float* df_lam; const float* df_sub; float* out; unsigned char* ws; int ph_lo, ph_hi; };

__device__ __forceinline__ int dst_row(int mode, int n) {
    if (mode == 1) { const int isu = n >= FF ? 1 : 0, j = n - isu * FF; return 256 * (j >> 7) + 128 * isu + (j & 127); }
    if (mode == 2) { if (n < 2048) { const int d = n & 63; return (n & ~63) + (d < 32 ? 2 * d : 2 * (d - 32) + 1); } return n; }
    return n;
}
__device__ __forceinline__ void transpose_item(const float* W, int K, int N, bf16* WT, int mode, LAS float* scr, int item, int lane) {
    const int nblk = N / 32, kb = item / nblk, nb = item % nblk, k0 = 64 * kb, n0 = 32 * nb;
#pragma unroll 8
    for (int i = 0; i < 32; ++i) { const int kk = 2 * i + (lane >> 5); scr[kk * 33 + (lane & 31)] = W[(size_t)(k0 + kk) * N + n0 + (lane & 31)]; }
    asm volatile("s_waitcnt lgkmcnt(0)" ::: "memory");
    const int c = lane & 7;
#pragma unroll
    for (int j = 0; j < 4; ++j) { const int n = (lane >> 3) + 8 * j; const LAS float* s = scr + (8 * c) * 33 + n;
        v4u o; o.x = pk2(s[0 * 33], s[1 * 33]); o.y = pk2(s[2 * 33], s[3 * 33]); o.z = pk2(s[4 * 33], s[5 * 33]); o.w = pk2(s[6 * 33], s[7 * 33]);
        *(v4u*)(WT + (size_t)dst_row(mode, n0 + n) * K + k0 + 8 * c) = o; }
    asm volatile("s_waitcnt lgkmcnt(0)" ::: "memory");
}
__device__ __forceinline__ void prologue(const Args& a, LAS unsigned char* lds) {
    const int tid = tid_opaque(), lane = tid & 63, wave = tid >> 6; const int bid = bid_opaque();
    LAS float* scr = (LAS float*)(lds + wave * 16384);
    const int gw = bid * 8 + wave, NGW = gridDim.x * 8;
    unsigned char* ws = a.ws;
    for (int mi = 0; mi < 12; ++mi) {
        const float* W; bf16* WT; int K, N, mode;
        if (mi < 4) { W = a.w_in + (size_t)mi * DM * NUP; WT = (bf16*)(ws + WS_WIN) + (size_t)mi * NUP * DM; K = DM; N = NUP; mode = 1; }
        else if (mi < 8) { W = a.w_out + (size_t)(mi - 4) * FF * DM; WT = (bf16*)(ws + WS_WOUT) + (size_t)(mi - 4) * DM * FF; K = FF; N = DM; mode = 0; }
        else if (mi == 8) { W = a.sb_qkv; WT = (bf16*)(ws + WS_WQKV); K = DM; N = NQKV; mode = 0; }
        else if (mi == 9) { W = a.df_qkv; WT = (bf16*)(ws + WS_WQKV) + (size_t)NQKV * DM; K = DM; N = NQKV; mode = 2; }
        else if (mi == 10) { W = a.sb_o; WT = (bf16*)(ws + WS_WO); K = DM; N = DM; mode = 0; }
        else { W = a.df_o; WT = (bf16*)(ws + WS_WO) + (size_t)DM * DM; K = DM; N = DM; mode = 0; }
        const int nit = (K / 64) * (N / 32);
        for (int it = gw; it < nit; it += NGW) transpose_item(W, K, N, WT, mode, scr, it, lane);
    }
    float* ssq = (float*)(ws + WS_SSQ); bf16* XA = (bf16*)(ws + WS_XA);
    f32x4 gv[4];
#pragma unroll
    for (int j = 0; j < 4; ++j) gv[j] = *((const f32x4*)a.ng + lane + 64 * j);
    for (int m = gw; m < M; m += NGW) {
        const f32x4* xr = (const f32x4*)(a.x + (size_t)m * DM) + lane; f32x4 v[4]; float s = 0.f;
#pragma unroll
        for (int j = 0; j < 4; ++j) { v[j] = xr[64 * j]; s += (v[j][0] * v[j][0] + v[j][1] * v[j][1]) + (v[j][2] * v[j][2] + v[j][3] * v[j][3]); }
        s = wave_sum(s);
        if (lane == 0) ssq[m] = s;
        unsigned long long* o8 = (unsigned long long*)(XA + (size_t)m * DM) + lane;
#pragma unroll
        for (int j = 0; j < 4; ++j) { const f32x4 t = v[j] * gv[j]; o8[64 * j] = (unsigned long long)pk2(t[0], t[1]) | ((unsigned long long)pk2(t[2], t[3]) << 32); }
    }
    const int gt = bid * 512 + tid, NGT = gridDim.x * 512;
    for (int i = gt; i < 6 * M; i += NGT) ssq[M + i] = 0.f;
    float* rc = (float*)(ws + WS_ROPE); float* rsn = rc + 2048 * 32;
    for (int i = gt; i < 2048 * 32; i += NGT) { const int pos = i >> 5, fi = i & 31;
        const float inv = __builtin_amdgcn_exp2f(-(float)fi * (13.287712379549449f / 32.0f));
        const float ang = (float)pos * inv;
        const double rev = (double)ang * 0.15915494309189535; const float fr = (float)(rev - rint(rev));
        rc[i] = __builtin_amdgcn_cosf(fr); rsn[i] = __builtin_amdgcn_sinf(fr); }
}
__device__ __forceinline__ void final_norm(const Args& a) {
    const int tid = tid_opaque(), lane = tid & 63, wave = tid >> 6; const int bid = bid_opaque();
    const int gw = bid * 8 + wave, NGW = gridDim.x * 8;
    const float* ssq = (const float*)(a.ws + WS_SSQ) + 6 * M;
    f32x4 gv[4];
#pragma unroll
    for (int j = 0; j < 4; ++j) gv[j] = *((const f32x4*)a.fg + lane + 64 * j);
    for (int m = gw; m < M; m += NGW) { const float rs = pg8::rstd_of(ssq[m]); f32x4* xr = (f32x4*)(a.out + (size_t)m * DM) + lane;
#pragma unroll
        for (int j = 0; j < 4; ++j) xr[64 * j] = xr[64 * j] * rs * gv[j]; }
}

__device__ __forceinline__ void sb_attn_naive(const bf16* Q, const bf16* K, const bf16* V, bf16* O) {
    const int tidn = tid_opaque();
    for (int it = bid_opaque(); it < 512; it += gridDim.x) {
        const int bh = it & 127, qb = 3 - (it >> 7), b = bh >> 4, h = bh & 15;
        const int t = qb * 512 + tidn;
        const uint4* qp = (const uint4*)(Q + ((size_t)(b * SEQ + t)) * DM + h * 64);
        float q[64], o[64];
#pragma unroll
        for (int j = 0; j < 8; ++j) { const uint4 w = qp[j]; q[8 * j] = bflo(w.x); q[8 * j + 1] = bfhi(w.x); q[8 * j + 2] = bflo(w.y); q[8 * j + 3] = bfhi(w.y); q[8 * j + 4] = bflo(w.z); q[8 * j + 5] = bfhi(w.z); q[8 * j + 6] = bflo(w.w); q[8 * j + 7] = bfhi(w.w); }
#pragma unroll
        for (int d = 0; d < 64; ++d) o[d] = 0.f;
        float R = 0.f;
        for (int s = qb * 512 + 511; s >= 0; --s) {
            const uint4* kp = (const uint4*)(K + ((size_t)(b * SEQ + s)) * DM + h * 64);
            float z = 0.f;
#pragma unroll
            for (int j = 0; j < 8; ++j) { const uint4 w = kp[j]; z += q[8 * j] * bflo(w.x) + q[8 * j + 1] * bfhi(w.x) + q[8 * j + 2] * bflo(w.y) + q[8 * j + 3] * bfhi(w.y) + q[8 * j + 4] * bflo(w.z) + q[8 * j + 5] * bfhi(w.z) + q[8 * j + 6] * bflo(w.w) + q[8 * j + 7] * bfhi(w.w); }
            if (s < t) {
                const float sp = fmaxf(z, 0.f) + __builtin_amdgcn_logf(1.0f + __builtin_amdgcn_exp2f(-fabsf(z)));
                const float aw = __builtin_amdgcn_exp2f((z - sp) + R);
                R -= sp;
                const uint4* vp = (const uint4*)(V + ((size_t)(b * SEQ + s)) * DM + h * 64);
#pragma unroll
                for (int j = 0; j < 8; ++j) { const uint4 w = vp[j]; o[8 * j] += aw * bflo(w.x); o[8 * j + 1] += aw * bfhi(w.x); o[8 * j + 2] += aw * bflo(w.y); o[8 * j + 3] += aw * bfhi(w.y); o[8 * j + 4] += aw * bflo(w.z); o[8 * j + 5] += aw * bfhi(w.z); o[8 * j + 6] += aw * bflo(w.w); o[8 * j + 7] += aw * bfhi(w.w); }
            }
        }
        uint4* op = (uint4*)(O + ((size_t)(b * SEQ + t)) * DM + h * 64);
#pragma unroll
        for (int j = 0; j < 8; ++j) { uint4 w; w.x = pk2(o[8 * j], o[8 * j + 1]); w.y = pk2(o[8 * j + 2], o[8 * j + 3]); w.z = pk2(o[8 * j + 4], o[8 * j + 5]); w.w = pk2(o[8 * j + 6], o[8 * j + 7]); op[j] = w; }
    }
}
__device__ __forceinline__ float diff_lambda(const float* lp) {
    float s1 = 0.f, s2 = 0.f;
    for (int i = 0; i < 64; ++i) { s1 += lp[i] * lp[64 + i]; s2 += lp[128 + i] * lp[192 + i]; }
    return expf(s1) - expf(s2) + LAMBDA_INIT;
}
__device__ __forceinline__ void diff_attn_naive(const bf16* Q, const bf16* K, const bf16* V, bf16* O, float* T, const float* lamp, const float* subg) {
    const float lam = diff_lambda(lamp);
    const int tidn = tid_opaque();
    for (int it = bid_opaque(); it < 256; it += gridDim.x) {
        const int bh = it & 63, qb = 3 - (it >> 6), b = bh >> 3, h = bh & 7;
        const int t = qb * 512 + tidn, kend = ((t >> 6) + 1) << 6;
        float* Tr = T + ((size_t)(b * SEQ + t)) * DM + h * 128;
        for (int vh = 0; vh < 2; ++vh)
            for (int mp = 0; mp < 2; ++mp) {
                const uint4* qp = (const uint4*)(Q + ((size_t)(b * SEQ + t)) * DM + (h * 2 + mp) * 64);
                float q[64], o[64];
#pragma unroll
                for (int j = 0; j < 8; ++j) { const uint4 w = qp[j]; q[8 * j] = bflo(w.x); q[8 * j + 1] = bfhi(w.x); q[8 * j + 2] = bflo(w.y); q[8 * j + 3] = bfhi(w.y); q[8 * j + 4] = bflo(w.z); q[8 * j + 5] = bfhi(w.z); q[8 * j + 6] = bflo(w.w); q[8 * j + 7] = bfhi(w.w); }
#pragma unroll
                for (int d = 0; d < 64; ++d) o[d] = 0.f;
                float mx = -1e30f, l = 0.f;
                for (int s = 0; s < qb * 512 + 512; ++s) {
                    const uint4* kp = (const uint4*)(K + ((size_t)(b * SEQ + s)) * DM + (h * 2 + mp) * 64);
                    float z = 0.f;
#pragma unroll
                    for (int j = 0; j < 8; ++j) { const uint4 w = kp[j]; z += q[8 * j] * bflo(w.x) + q[8 * j + 1] * bfhi(w.x) + q[8 * j + 2] * bflo(w.y) + q[8 * j + 3] * bfhi(w.y) + q[8 * j + 4] * bflo(w.z) + q[8 * j + 5] * bfhi(w.z) + q[8 * j + 6] * bflo(w.w) + q[8 * j + 7] * bfhi(w.w); }
                    if (s < kend) {
                        const float mn = fmaxf(mx, z), f = __builtin_amdgcn_exp2f(mx - mn), p = __builtin_amdgcn_exp2f(z - mn);
                        mx = mn; l = l * f + p;
                        const uint4* vp = (const uint4*)(V + ((size_t)(b * SEQ + s)) * DM + h * 128 + vh * 64);
#pragma unroll
                        for (int j = 0; j < 8; ++j) { const uint4 w = vp[j]; o[8 * j] = o[8 * j] * f + p * bflo(w.x); o[8 * j + 1] = o[8 * j + 1] * f + p * bfhi(w.x); o[8 * j + 2] = o[8 * j + 2] * f + p * bflo(w.y); o[8 * j + 3] = o[8 * j + 3] * f + p * bfhi(w.y);
                            o[8 * j + 4] = o[8 * j + 4] * f + p * bflo(w.z); o[8 * j + 5] = o[8 * j + 5] * f + p * bfhi(w.z); o[8 * j + 6] = o[8 * j + 6] * f + p * bflo(w.w); o[8 * j + 7] = o[8 * j + 7] * f + p * bfhi(w.w); }
                    }
                }
                const float il = 1.0f / l;
                if (mp == 0) {
#pragma unroll
                    for (int d = 0; d < 64; d += 4) *(f32x4*)(Tr + vh * 64 + d) = (f32x4){o[d] * il, o[d + 1] * il, o[d + 2] * il, o[d + 3] * il};
                } else {
#pragma unroll
                    for (int d = 0; d < 64; d += 4) { const f32x4 p1 = *(const f32x4*)(Tr + vh * 64 + d);
                        *(f32x4*)(Tr + vh * 64 + d) = (f32x4){p1[0] - lam * o[d] * il, p1[1] - lam * o[d + 1] * il, p1[2] - lam * o[d + 2] * il, p1[3] - lam * o[d + 3] * il}; }
                }
            }
        float ss = 0.f;
        for (int d = 0; d < 128; d += 4) { const f32x4 v = *(const f32x4*)(Tr + d); ss += (v[0] * v[0] + v[1] * v[1]) + (v[2] * v[2] + v[3] * v[3]); }
        const float rs = (1.0f / sqrtf(ss * (1.0f / 128.0f) + 1e-6f)) * (1.0f - LAMBDA_INIT);
        bf16* Or = O + ((size_t)(b * SEQ + t)) * DM + h * 128;
        for (int d = 0; d < 128; d += 4) { const f32x4 v = *(const f32x4*)(Tr + d); const f32x4 g = *(const f32x4*)(subg + d);
            uint2 w; w.x = pk2(v[0] * rs * g[0], v[1] * rs * g[1]); w.y = pk2(v[2] * rs * g[2], v[3] * rs * g[3]); *(uint2*)(Or + d) = w; }
    }
}
#ifndef MK_MULTI
#define MK_MULTI 0
#endif
__global__ void __launch_bounds__(512, 2) mega(Args a_in) {
    extern __shared__ __attribute__((aligned(16))) unsigned char lds_raw[];
    LAS unsigned char* lds = (LAS unsigned char*)lds_raw;
    cg::grid_group grid = cg::this_grid();
    const int ph_lo = a_in.ph_lo, ph_hi = a_in.ph_hi;
    for (int p = ph_lo; p < ph_hi; ++p) {
#if defined(MK_REREAD)

    unsigned long long apv = (unsigned long long)__builtin_amdgcn_kernarg_segment_ptr();
    unsigned aplo = (unsigned)apv, aphi = (unsigned)(apv >> 32); asm volatile("" : "+s"(aplo), "+s"(aphi));
    aplo = __builtin_amdgcn_readfirstlane(aplo); aphi = __builtin_amdgcn_readfirstlane(aphi);
    const __attribute__((address_space(4))) unsigned char* ap = (const __attribute__((address_space(4))) unsigned char*)(((unsigned long long)aphi << 32) | aplo);
    Args a; __builtin_memcpy(&a, ap, sizeof(Args));
#else
    const Args a = a_in;
#endif
    unsigned char* ws = a.ws;
    float* ssq = (float*)(ws + WS_SSQ);
    bf16* XA = (bf16*)(ws + WS_XA); bf16* H = (bf16*)(ws + WS_H); bf16* Q = (bf16*)(ws + WS_Q); bf16* Kb = (bf16*)(ws + WS_K); bf16* Vb = (bf16*)(ws + WS_V); bf16* O = (bf16*)(ws + WS_O);
    const bf16* Win = (const bf16*)(ws + WS_WIN); const bf16* Wout = (const bf16*)(ws + WS_WOUT); const bf16* Wqkv = (const bf16*)(ws + WS_WQKV); const bf16* Wo = (const bf16*)(ws + WS_WO);
    const int G = gridDim.x, c = bid_opaque();
    {
        if (p == 0) {
#ifndef NO_PRO
 prologue(a, lds);
#endif
 }
        else if (p == NPHASE - 1) final_norm(a);
        else {
            const int L = (p - 1) / 7, s = (p - 1) % 7;
            if (s == 0 || s == 5) {
                const int ab = (s == 5) ? 1 : 0;
                pg8::Gemm g{XA, Win + (size_t)(L * 2 + ab) * NUP * DM, M, NUP, DM}; pg8::StaticOrder S; S.init(M, NUP, G, c);
                pg8::EpiSwiglu E{H, ssq + (size_t)(3 * L + 2 * ab) * M, FF};

#ifndef NO_UP
 pg8::gemm_phase<pg8::EpiSwiglu, pg8::StaticOrder, true, true>(lds, g, S, E);
#endif

            } else if (s == 1 || s == 4 || s == 6) {
                const bf16* A; const bf16* Bt; int K; float alpha; int nn; const float* gain;
                if (s == 4) { A = O; Bt = Wo + (size_t)L * DM * DM; K = DM; alpha = 1.0f; nn = 3 * L + 2; gain = a.ng + (size_t)(3 * L + 2) * DM; }
                else if (s == 1) { A = H; Bt = Wout + (size_t)(L * 2) * DM * FF; K = FF; alpha = 0.5f; nn = 3 * L + 1; gain = a.ng + (size_t)(3 * L + 1) * DM; }
                else { A = H; Bt = Wout + (size_t)(L * 2 + 1) * DM * FF; K = FF; alpha = 0.5f; nn = 3 * L + 3; gain = (L == 1) ? a.fg : a.ng + (size_t)(3 * L + 3) * DM; }
                pg8::Gemm g{A, Bt, M, DM, K}; pg8::StaticOrder S; S.init(M, DM, G, c);
                pg8::EpiRes E{(p == 2) ? a.x : a.out, a.out, XA, gain, ssq + (size_t)nn * M, alpha};

#ifndef NO_RES
 pg8::gemm_phase<pg8::EpiRes, pg8::StaticOrder, true, true>(lds, g, S, E);
#endif

            } else if (s == 2) {
                pg8::Gemm g{XA, Wqkv + (size_t)L * NQKV * DM, M, NQKV, DM}; pg8::StaticOrder S; S.init(M, NQKV, G, c);
                const float* rc = (const float*)(ws + WS_ROPE);
                pg8::EpiQKV E{Q, (size_t)(WS_K - WS_Q) / 2, ssq + (size_t)(3 * L + 1) * M, QSCALE, L == 1 ? rc : nullptr, rc + 2048 * 32};

#ifndef NO_QKV
 pg8::gemm_phase<pg8::EpiQKV, pg8::StaticOrder, true, true>(lds, g, S, E);
#endif

            } else {

#ifndef NO_SB
 if (L == 0) sb_attn_naive(Q, Kb, Vb, O);
#endif
#ifndef NO_DF

                if (L == 1) diff_attn_naive(Q, Kb, Vb, O, (float*)(ws + WS_T), a.df_lam, a.df_sub);
#endif

            }
        }
        if (p + 1 < ph_hi) grid.sync();
    }
    }
}

extern "C" void kernel_launch(void* const* d_in, const int* in_sizes, int n_in, void* d_out, int out_size, void* d_ws, size_t ws_size, hipStream_t stream) {
    static int grid = 0;
    if (grid == 0) {
        if (n_in != 11 || in_sizes[0] != M * DM || out_size != M * DM || ws_size < WS_END) { fprintf(stderr, "kernel_launch: unexpected shapes (n_in %d, in0 %d, out %d, ws %zu)\n", n_in, n_in > 0 ? in_sizes[0] : -1, out_size, ws_size); grid = -1; return; }
        int dev = 0, cus = 0, per_cu = 0;
        if (hipGetDevice(&dev) != hipSuccess || hipDeviceGetAttribute(&cus, hipDeviceAttributeMultiprocessorCount, dev) != hipSuccess) { grid = -1; return; }
        if (hipFuncSetAttribute((const void*)mega, hipFuncAttributeMaxDynamicSharedMemorySize, LDS_BYTES) != hipSuccess) { fprintf(stderr, "kernel_launch: hipFuncSetAttribute failed\n"); grid = -1; return; }
        if (hipOccupancyMaxActiveBlocksPerMultiprocessor(&per_cu, (const void*)mega, 512, LDS_BYTES) != hipSuccess || per_cu < 1) { fprintf(stderr, "kernel_launch: occupancy query gave %d\n", per_cu); per_cu = 1; }
        (void)hipGetLastError();
        grid = cus * (per_cu > 1 ? 1 : per_cu);
    }
    if (grid < 0) return;
    Args a{};
    a.x = (const float*)d_in[0]; a.ng = (const float*)d_in[1]; a.fg = (const float*)d_in[2]; a.w_in = (const float*)d_in[3]; a.w_out = (const float*)d_in[4];
    a.sb_qkv = (const float*)d_in[5]; a.sb_o = (const float*)d_in[6]; a.df_qkv = (const float*)d_in[7]; a.df_o = (const float*)d_in[8]; a.df_lam = (const float*)d_in[9]; a.df_sub = (const float*)d_in[10];
    a.out = (float*)d_out; a.ws = (unsigned char*)d_ws;
#if MK_MULTI
    for (int p = 0; p < NPHASE; ++p) { a.ph_lo = p; a.ph_hi = p + 1; hipLaunchKernelGGL(mega, dim3(grid), dim3(512), LDS_BYTES, stream, a); }
#else
    a.ph_lo = 0; a.ph_hi = NPHASE;
    void* args[] = {&a};
    hipError_t e = hipLaunchCooperativeKernel((const void*)mega, dim3(grid), dim3(512), args, LDS_BYTES, stream);
    if (e != hipSuccess) fprintf(stderr, "cooperative launch failed: %s (grid %d)\n", hipGetErrorString(e), grid);
#endif
}
```

```cpp
#include <hip/hip_runtime.h>
#include <hip/hip_cooperative_groups.h>
#include <cstdio>
#include <cstdint>
namespace cg = cooperative_groups;
namespace pg8 {
#define PG8_LAS __attribute__((address_space(3)))
typedef unsigned short bf16_t;
typedef short bf16x8 __attribute__((ext_vector_type(8)));
typedef float f32x4 __attribute__((ext_vector_type(4)));
typedef unsigned u32x4 __attribute__((ext_vector_type(4)));
constexpr int BM = 256, BK = 64, HALF = 128, HTB = HALF * BK * 2  , STAGE_BYTES = 8 * HTB, NXCD = 8, WGM = 8;

__host__ __device__ __forceinline__ int lds_byte(int r, int c) { const int st = (r >> 4) * 2 + (c >> 5), rr = r & 15, cc = c & 31, ob = rr * 64 + cc * 2; return st * 1024 + (ob ^ (((ob >> 9) & 1) << 5)); }
__host__ __device__ __forceinline__ void stage_rc(int b, int& R, int& C) { const int st = b / 1024, sb = b % 1024, swz = sb ^ (((sb >> 9) & 1) << 5); R = (st >> 1) * 16 + swz / 64; C = (st & 1) * 32 + (swz % 64) / 2; }
__host__ __device__ __forceinline__ int perm32(int rho) { const int n = rho >> 4, i = rho & 15; return 8 * (i >> 2) + 4 * n + (i & 3); }

struct Unit { int pm, pn; };
struct Gemm { const bf16_t* A; const bf16_t* Bt; int M, N, K; };

struct StaticOrder {
    int nM, nN, nwg, G, c;
    __host__ __device__ void init(int M, int N, int G_, int c_) { nM = M / BM; nN = N / BM; nwg = nM * nN; G = G_; c = c_; }
    __host__ __device__ bool next(int i, Unit& u) const {
        const long L = (long)i * G + c; if (L >= nwg) return false;
        int wgid = (int)L; { const int q = nwg / NXCD, r = nwg % NXCD, xcd = wgid % NXCD, off = wgid / NXCD; wgid = (xcd < r ? xcd * (q + 1) : r * (q + 1) + (xcd - r) * q) + off; }
        const int nig = WGM * nN, gid = wgid / nig, fm = gid * WGM, gsz = (nM - fm) < WGM ? (nM - fm) : WGM;
        u.pm = fm + ((wgid % nig) % gsz); u.pn = (wgid % nig) / gsz; return true;
    }
    __device__ __forceinline__ void a_ready(const Unit&) const {}
    __device__ __forceinline__ void done(const Unit&) const {}
};
__device__ __forceinline__ unsigned cvt_pk_bf16(float lo, float hi) { unsigned r; asm volatile("v_cvt_pk_bf16_f32 %0, %1, %2" : "=v"(r) : "v"(lo), "v"(hi)); return r; }
typedef float f32x2 __attribute__((ext_vector_type(2)));
__device__ __forceinline__ float rstd_of(float ssq) { return 1.0f / sqrtf(ssq * (1.0f / 1024.0f) + 1e-6f); }
struct EpiSwiglu {
    static constexpr bool PERM = true, AFTER_DRAIN = false;
    bf16_t* H; const float* ssq; int ldh;
    __device__ __forceinline__ void operator()(const f32x4 (&acc)[2][2][4][2], const Unit& u, int wr, int wc, int fr, int fq) const {
        const int row0 = u.pm * BM + wr * 64 + fr, hcol = u.pn * HALF + wc * 32 + 8 * fq;
#pragma unroll
        for (int ai = 0; ai < 2; ++ai)
#pragma unroll
            for (int m = 0; m < 4; ++m) { const int row = row0 + ai * HALF + m * 16; const float rs = rstd_of(ssq[row]);
                float hv[8];
#pragma unroll
                for (int n = 0; n < 2; ++n)
#pragma unroll
                    for (int e = 0; e < 4; ++e) { const float g = acc[ai][0][m][n][e] * rs, up = acc[ai][1][m][n][e] * rs;
                        const float ex = __builtin_amdgcn_exp2f(-g * 1.4426950408889634f);
                        hv[n * 4 + e] = g * up * __builtin_amdgcn_rcpf(1.0f + ex); }
                u32x4 w; w.x = cvt_pk_bf16(hv[0], hv[1]); w.y = cvt_pk_bf16(hv[2], hv[3]); w.z = cvt_pk_bf16(hv[4], hv[5]); w.w = cvt_pk_bf16(hv[6], hv[7]);
                *(u32x4*)(H + (size_t)row * ldh + hcol) = w; }
    }
};
struct EpiRes {
    static constexpr bool PERM = true, AFTER_DRAIN = false;
    const float* base; float* out; bf16_t* xa; const float* gain; float* ssq; float alpha;
    __device__ __forceinline__ void operator()(const f32x4 (&acc)[2][2][4][2], const Unit& u, int wr, int wc, int fr, int fq) const {
        const int row0 = u.pm * BM + wr * 64 + fr, col0 = u.pn * BM + wc * 32 + 8 * fq;
        f32x4 gv[2][2];
#pragma unroll
        for (int bj = 0; bj < 2; ++bj)
#pragma unroll
            for (int n = 0; n < 2; ++n) gv[bj][n] = *(const f32x4*)(gain + col0 + bj * HALF + 4 * n);
#pragma unroll
        for (int ai = 0; ai < 2; ++ai)
#pragma unroll
            for (int m = 0; m < 4; ++m) { const int row = row0 + ai * HALF + m * 16; float s = 0.f;
#pragma unroll
                for (int bj = 0; bj < 2; ++bj) { const size_t off = (size_t)row * 1024 + col0 + bj * HALF;
                    const f32x4 b0 = *(const f32x4*)(base + off), b1 = *(const f32x4*)(base + off + 4);
                    const f32x4 v0 = b0 + acc[ai][bj][m][0] * alpha, v1 = b1 + acc[ai][bj][m][1] * alpha;
                    *(f32x4*)(out + off) = v0; *(f32x4*)(out + off + 4) = v1;
                    s += (v0[0] * v0[0] + v0[1] * v0[1]) + (v0[2] * v0[2] + v0[3] * v0[3]) + (v1[0] * v1[0] + v1[1] * v1[1]) + (v1[2] * v1[2] + v1[3] * v1[3]);
                    const f32x4 a0 = v0 * gv[bj][0], a1 = v1 * gv[bj][1];
                    u32x4 w; w.x = cvt_pk_bf16(a0[0], a0[1]); w.y = cvt_pk_bf16(a0[2], a0[3]); w.z = cvt_pk_bf16(a1[0], a1[1]); w.w = cvt_pk_bf16(a1[2], a1[3]);
                    *(u32x4*)(xa + off) = w; }
                s += __shfl_xor(s, 16); s += __shfl_xor(s, 32);
                if (fq == 0) __hip_atomic_fetch_add(ssq + row, s, __ATOMIC_RELAXED, __HIP_MEMORY_SCOPE_AGENT); }
    }
};
struct EpiQKV {
    static constexpr bool PERM = true, AFTER_DRAIN = false;
    bf16_t* O; size_t stride; const float* ssq; float qscale; const float* rcos; const float* rsin;
    __device__ __forceinline__ void operator()(const f32x4 (&acc)[2][2][4][2], const Unit& u, int wr, int wc, int fr, int fq) const {
        const int t = u.pn >> 2, colt = (u.pn & 3) * BM;
        bf16_t* basep = O + (size_t)t * stride;
        const int row0 = u.pm * BM + wr * 64 + fr, col0 = colt + wc * 32 + 8 * fq;
        const float sc0 = (t == 0) ? qscale : 1.0f;
        const bool dorope = (rcos != nullptr) && (t < 2);
        const int pr0 = (wc & 1) * 16 + 4 * fq;
        if (t == 2) {
#pragma unroll
            for (int ai = 0; ai < 2; ++ai)
#pragma unroll
                for (int m = 0; m < 4; ++m) { const int row = row0 + ai * HALF + m * 16; const float sc = rstd_of(ssq[row]);
                    bf16_t* vp = basep + ((size_t)((row >> 11) * 1024 + col0)) * 2048 + (row & 2047);
#pragma unroll
                    for (int bj = 0; bj < 2; ++bj)
#pragma unroll
                        for (int n = 0; n < 2; ++n)
#pragma unroll
                            for (int e = 0; e < 4; ++e) { const unsigned w = cvt_pk_bf16(acc[ai][bj][m][n][e] * sc, 0.f); vp[(size_t)(bj * HALF + n * 4 + e) * 2048] = (bf16_t)w; } }
            return;
        }
#pragma unroll
        for (int ai = 0; ai < 2; ++ai)
#pragma unroll
            for (int m = 0; m < 4; ++m) { const int row = row0 + ai * HALF + m * 16; const float sc = rstd_of(ssq[row]) * sc0;
                f32x4 cs = (f32x4){1.f, 1.f, 1.f, 1.f}, sn = (f32x4){0.f, 0.f, 0.f, 0.f};
                if (dorope) { const int pos = row & 2047; cs = *(const f32x4*)(rcos + pos * 32 + pr0); sn = *(const f32x4*)(rsin + pos * 32 + pr0); }
#pragma unroll
                for (int bj = 0; bj < 2; ++bj) { const f32x4 v0 = acc[ai][bj][m][0] * sc, v1 = acc[ai][bj][m][1] * sc;
                    float o[8];
                    o[0] = v0[0] * cs[0] - v0[1] * sn[0]; o[1] = v0[1] * cs[0] + v0[0] * sn[0];
                    o[2] = v0[2] * cs[1] - v0[3] * sn[1]; o[3] = v0[3] * cs[1] + v0[2] * sn[1];
                    o[4] = v1[0] * cs[2] - v1[1] * sn[2]; o[5] = v1[1] * cs[2] + v1[0] * sn[2];
                    o[6] = v1[2] * cs[3] - v1[3] * sn[3]; o[7] = v1[3] * cs[3] + v1[2] * sn[3];
                    u32x4 w; w.x = cvt_pk_bf16(o[0], o[1]); w.y = cvt_pk_bf16(o[2], o[3]); w.z = cvt_pk_bf16(o[4], o[5]); w.w = cvt_pk_bf16(o[6], o[7]);
                    *(u32x4*)(basep + (size_t)row * 1024 + col0 + bj * HALF) = w; } }
    }
};
template <class Epi, class Sched, bool ALIGN_EPI = false, bool SP2 = false>
__device__ __forceinline__ void gemm_phase(PG8_LAS unsigned char* lds, const Gemm g, const Sched& S, const Epi& E) {
    int tid_ = threadIdx.x; asm volatile("" : "+v"(tid_));
    const int tid = tid_, wid = __builtin_amdgcn_readfirstlane(tid >> 6), lane = tid & 63, wr = wid >> 2, wc = wid & 3, fr = lane & 15, fq = lane >> 4;
    const int K = g.K, nt = K / BK;
    unsigned voffA[2], voffB[2];
#pragma unroll
    for (int i = 0; i < 2; ++i) { int R, C; stage_rc(tid * 16 + i * 8192, R, C); const int Rb = Epi::PERM ? ((R & ~31) + perm32(R & 31)) : R;
        voffA[i] = (unsigned)(R * K + C) * 2u; voffB[i] = (unsigned)(Rb * K + C) * 2u; }
    const size_t kstep = (size_t)(BK * 2);
    const size_t hstep = (size_t)HALF * K * 2;
    const size_t tstep = 2 * hstep;
    const unsigned ldsw = (unsigned)wid * 1024u;
    const int aoff = lds_byte(wr * 64 + fr, fq * 8), boff = lds_byte(wc * 32 + fr, fq * 8);
#define PG8_SA(b, h) (((b) * 2 + (h)) * HTB)
#define PG8_SB(b, h) ((4 + (b) * 2 + (h)) * HTB)
#define PG8_STAGE(bufoff, gbase, voff) do { _Pragma("unroll") for (int _i = 0; _i < 2; ++_i) \
        __builtin_amdgcn_global_load_lds((const unsigned*)((const char*)(gbase) + (voff)[_i]), (PG8_LAS unsigned*)(lds + (bufoff) + ldsw + _i * 8192), 16, 0, 0); } while (0)
#define PG8_LDA(dst, b, h) do { _Pragma("unroll") for (int m = 0; m < 4; ++m) _Pragma("unroll") for (int k = 0; k < 2; ++k) dst[m][k] = *(const PG8_LAS bf16x8*)(lds + PG8_SA(b, h) + aoff + m * 2048 + k * 1024); } while (0)
#define PG8_LDB(dst, b, h) do { _Pragma("unroll") for (int n = 0; n < 2; ++n) _Pragma("unroll") for (int k = 0; k < 2; ++k) dst[n][k] = *(const PG8_LAS bf16x8*)(lds + PG8_SB(b, h) + boff + n * 2048 + k * 1024); } while (0)
#define PG8_MMA(ai, bj, At, Bt) do { __builtin_amdgcn_s_setprio(1); _Pragma("unroll") for (int m = 0; m < 4; ++m) _Pragma("unroll") for (int n = 0; n < 2; ++n) _Pragma("unroll") for (int k = 0; k < 2; ++k) \
        acc[ai][bj][m][n] = __builtin_amdgcn_mfma_f32_16x16x32_bf16(Bt[n][k], At[m][k], acc[ai][bj][m][n], 0, 0, 0); __builtin_amdgcn_s_setprio(0); } while (0)
#define PG8_WAIT_V(n) asm volatile("s_waitcnt vmcnt(" #n ")" ::: "memory")
#define PG8_WAIT_L(n) asm volatile("s_waitcnt lgkmcnt(" #n ")" ::: "memory")
#define PG8_BAR __builtin_amdgcn_s_barrier()
#define PG8_SCHED __builtin_amdgcn_sched_barrier(0)
    Unit cur, nxt; int ui = 0;
    if (!S.next(0, cur)) return;
    f32x4 acc[2][2][4][2];
#pragma unroll
    for (int a = 0; a < 2; ++a)
#pragma unroll
        for (int b = 0; b < 2; ++b)
#pragma unroll
            for (int m = 0; m < 4; ++m)
#pragma unroll
                for (int n = 0; n < 2; ++n) acc[a][b][m][n] = (f32x4){0.f, 0.f, 0.f, 0.f};
    bf16x8 At[4][2], B0[2][2], B1[2][2];
    const char* cA = (const char*)g.A + (size_t)cur.pm * tstep; const char* cB = (const char*)g.Bt + (size_t)cur.pn * tstep;
    S.a_ready(cur);
    if constexpr (SP2) {
        PG8_STAGE(PG8_SB(0, 0), cB, voffB); PG8_STAGE(PG8_SB(0, 1), cB + hstep, voffB); PG8_STAGE(PG8_SA(0, 0), cA, voffA); PG8_STAGE(PG8_SA(0, 1), cA + hstep, voffA);
        if (wr == 1) PG8_BAR;
        PG8_WAIT_V(2); PG8_BAR;
        PG8_STAGE(PG8_SB(1, 0), cB + kstep, voffB); PG8_STAGE(PG8_SA(1, 0), cA + kstep, voffA); PG8_STAGE(PG8_SB(1, 1), cB + hstep + kstep, voffB);
        PG8_WAIT_V(6); PG8_BAR;
    } else {
        PG8_STAGE(PG8_SB(0, 0), cB, voffB); PG8_STAGE(PG8_SA(0, 0), cA, voffA); PG8_STAGE(PG8_SB(0, 1), cB + hstep, voffB); PG8_STAGE(PG8_SA(0, 1), cA + hstep, voffA);
        if (wr == 1) PG8_BAR;
        PG8_WAIT_V(4); PG8_BAR;
        PG8_STAGE(PG8_SB(1, 0), cB + kstep, voffB); PG8_STAGE(PG8_SA(1, 0), cA + kstep, voffA); PG8_STAGE(PG8_SB(1, 1), cB + hstep + kstep, voffB);
        PG8_WAIT_V(6); PG8_BAR;
    }
    for (;;) {
        const bool has_next = S.next(ui + 1, nxt);
        const char* nA = has_next ? (const char*)g.A + (size_t)nxt.pm * tstep : cA; const char* nB = has_next ? (const char*)g.Bt + (size_t)nxt.pn * tstep : cB;
        for (int t = 0; t < nt; t += 2) {
            const bool last = (t == nt - 2);
            const char* a1 = cA + (size_t)(t + 1) * kstep;
            const char* a2 = last ? nA : cA + (size_t)(t + 2) * kstep; const char* b2 = last ? nB : cB + (size_t)(t + 2) * kstep;
            const char* a3 = a2 + kstep; const char* b3 = b2 + kstep;
            if (last && has_next) S.a_ready(nxt);
            if constexpr (SP2) {
            PG8_LDB(B0, 0, 0); PG8_LDB(B1, 0, 1); PG8_SCHED; PG8_LDA(At, 0, 0); PG8_STAGE(PG8_SA(1, 1), a1 + hstep, voffA);
            PG8_WAIT_V(8); PG8_WAIT_L(0); PG8_BAR; PG8_MMA(0, 0, At, B0); PG8_MMA(0, 1, At, B1); PG8_BAR; PG8_SCHED;
            PG8_LDA(At, 0, 1); PG8_STAGE(PG8_SB(0, 0), b2, voffB); PG8_STAGE(PG8_SB(0, 1), b2 + hstep, voffB); PG8_STAGE(PG8_SA(0, 0), a2, voffA);
            PG8_WAIT_V(8); PG8_WAIT_L(0); PG8_BAR; PG8_MMA(1, 0, At, B0); PG8_MMA(1, 1, At, B1); PG8_BAR; PG8_SCHED;
            PG8_LDB(B0, 1, 0); PG8_LDB(B1, 1, 1); PG8_SCHED; PG8_LDA(At, 1, 0); PG8_STAGE(PG8_SA(0, 1), a2 + hstep, voffA);
            PG8_WAIT_V(8); PG8_WAIT_L(0); PG8_BAR; PG8_MMA(0, 0, At, B0); PG8_MMA(0, 1, At, B1); PG8_BAR; PG8_SCHED;
            PG8_LDA(At, 1, 1); PG8_STAGE(PG8_SB(1, 0), b3, voffB); PG8_STAGE(PG8_SB(1, 1), b3 + hstep, voffB); PG8_STAGE(PG8_SA(1, 0), a3, voffA);
            PG8_WAIT_V(8); PG8_WAIT_L(0); PG8_BAR; PG8_MMA(1, 0, At, B0); PG8_MMA(1, 1, At, B1); PG8_BAR; PG8_SCHED;
            } else {
            PG8_LDB(B0, 0, 0); PG8_SCHED; PG8_LDA(At, 0, 0); PG8_STAGE(PG8_SA(1, 1), a1 + hstep, voffA);
            PG8_WAIT_L(8); PG8_BAR; PG8_WAIT_L(0); PG8_MMA(0, 0, At, B0); PG8_BAR; PG8_SCHED;
            PG8_LDB(B1, 0, 1); PG8_STAGE(PG8_SB(0, 0), b2, voffB);
            PG8_BAR; PG8_WAIT_L(0); PG8_MMA(0, 1, At, B1); PG8_BAR;
            PG8_LDA(At, 0, 1); PG8_STAGE(PG8_SA(0, 0), a2, voffA);
            PG8_BAR; PG8_WAIT_L(0); PG8_MMA(1, 0, At, B0); PG8_BAR; PG8_SCHED;
            PG8_STAGE(PG8_SB(0, 1), b2 + hstep, voffB);
            PG8_WAIT_V(6); PG8_BAR; PG8_MMA(1, 1, At, B1); PG8_BAR;
            PG8_LDB(B0, 1, 0); PG8_SCHED; PG8_LDA(At, 1, 0); PG8_STAGE(PG8_SA(0, 1), a2 + hstep, voffA);
            PG8_WAIT_L(8); PG8_BAR; PG8_WAIT_L(0); PG8_MMA(0, 0, At, B0); PG8_BAR; PG8_SCHED;
            PG8_LDB(B1, 1, 1); PG8_STAGE(PG8_SB(1, 0), b3, voffB);
            PG8_BAR; PG8_WAIT_L(0); PG8_MMA(0, 1, At, B1); PG8_BAR;
            PG8_LDA(At, 1, 1); PG8_STAGE(PG8_SA(1, 0), a3, voffA);
            PG8_BAR; PG8_WAIT_L(0); PG8_MMA(1, 0, At, B0); PG8_BAR; PG8_SCHED;
            PG8_STAGE(PG8_SB(1, 1), b3 + hstep, voffB);
            PG8_WAIT_V(6); PG8_BAR; PG8_MMA(1, 1, At, B1); PG8_BAR;
            }
        }
        if constexpr (ALIGN_EPI) { if (wr == 0) PG8_BAR; }
        if constexpr (!Epi::AFTER_DRAIN) { E(acc, cur, wr, wc, fr, fq); S.done(cur); }
        if (!has_next) break;
#pragma unroll
        for (int a = 0; a < 2; ++a)
#pragma unroll
            for (int b = 0; b < 2; ++b)
#pragma unroll
                for (int m = 0; m < 4; ++m)
#pragma unroll
                    for (int n = 0; n < 2; ++n) acc[a][b][m][n] = (f32x4){0.f, 0.f, 0.f, 0.f};
        cur = nxt; cA = nA; cB = nB; ++ui;
        if constexpr (ALIGN_EPI) { if (wr == 1) PG8_BAR; }
    }
    PG8_WAIT_V(0);
    if constexpr (!ALIGN_EPI) { if (wr == 0) PG8_BAR; }
    PG8_BAR;
    if constexpr (Epi::AFTER_DRAIN) { E.fused(acc, cur, wr, wc, fr, fq, lds, wid, lane); S.done(cur); }
#undef PG8_SA
#undef PG8_SB
#undef PG8_STAGE
#undef PG8_LDA
#undef PG8_LDB
#undef PG8_MMA
#undef PG8_WAIT_V
#undef PG8_WAIT_L
#undef PG8_BAR
#undef PG8_SCHED
}
}
constexpr int SEQ = 2048, NB = 8, DM = 1024, M = NB * SEQ, FF = 2816, NUP = 2 * FF, NQKV = 3 * DM;
constexpr float QSCALE = 0.125f * 1.4426950408889634f;
constexpr float LAMBDA_INIT = 0.35550906f;
constexpr size_t MiB = 1u << 20;
constexpr size_t WS_SSQ = 256 * 1024;
constexpr size_t WS_ROPE = 1 * MiB;
constexpr size_t WS_WIN = 2 * MiB;
constexpr size_t WS_WOUT = 46 * MiB;
constexpr size_t WS_WQKV = 68 * MiB;
constexpr size_t WS_WO = 80 * MiB;
constexpr size_t WS_XA = 84 * MiB;
constexpr size_t WS_H = 116 * MiB;
constexpr size_t WS_Q = 116 * MiB, WS_K = 148 * MiB, WS_V = 180 * MiB;
constexpr size_t WS_O = 212 * MiB;
constexpr size_t WS_T = 244 * MiB;
constexpr size_t WS_END = 308 * MiB;
constexpr int LDS_BYTES = 147456;
constexpr int NPHASE = 16;

#define GAS __attribute__((address_space(1)))
#define LAS __attribute__((address_space(3)))
typedef unsigned short bf16;
typedef unsigned v4u __attribute__((ext_vector_type(4)));
typedef float f32x4 __attribute__((ext_vector_type(4)));
__device__ __forceinline__ unsigned f2bf(float f) { unsigned u = __builtin_bit_cast(unsigned, f); return (u + 0x7fffu + ((u >> 16) & 1u)) >> 16; }
__device__ __forceinline__ unsigned pk2(float lo, float hi) { return f2bf(lo) | (f2bf(hi) << 16); }
__device__ __forceinline__ float bflo(unsigned u) { return __uint_as_float(u << 16); }
__device__ __forceinline__ float bfhi(unsigned u) { return __uint_as_float(u & 0xffff0000u); }
__device__ __forceinline__ int tid_opaque() { int t = threadIdx.x; asm volatile("" : "+v"(t)); return t; }
__device__ __forceinline__ int bid_opaque() { int t = blockIdx.x; asm volatile("" : "+s"(t)); return t; }
__device__ __forceinline__ float wave_sum(float v) {
#pragma unroll
    for (int o = 1; o < 64; o <<= 1) v += __shfl_xor(v, o);
    return v;
}

struct Args { const float* x; const float* ng; const float* fg; const float* w_in; const float* w_out; const float* sb_qkv; const float* sb_o;
              const float* df_qkv; const float* df_o; const float* df_lam; const float* df_sub; float* out; unsigned char* ws; int ph_lo, ph_hi; };

__device__ __forceinline__ int dst_row(int mode, int n) {
    if (mode == 1) { const int isu = n >= FF ? 1 : 0, j = n - isu * FF; return 256 * (j >> 7) + 128 * isu + (j & 127); }
    if (mode == 2) { if (n < 2048) { const int d = n & 63; return (n & ~63) + (d < 32 ? 2 * d : 2 * (d - 32) + 1); } return n; }
    return n;
}
__device__ __forceinline__ void transpose_item(const float* W, int K, int N, bf16* WT, int mode, LAS float* scr, int item, int lane) {
    const int nblk = N / 32, kb = item / nblk, nb = item % nblk, k0 = 64 * kb, n0 = 32 * nb;
#pragma unroll 8
    for (int i = 0; i < 32; ++i) { const int kk = 2 * i + (lane >> 5); scr[kk * 33 + (lane & 31)] = W[(size_t)(k0 + kk) * N + n0 + (lane & 31)]; }
    asm volatile("s_waitcnt lgkmcnt(0)" ::: "memory");
    const int c = lane & 7;
#pragma unroll
    for (int j = 0; j < 4; ++j) { const int n = (lane >> 3) + 8 * j; const LAS float* s = scr + (8 * c) * 33 + n;
        v4u o; o.x = pk2(s[0 * 33], s[1 * 33]); o.y = pk2(s[2 * 33], s[3 * 33]); o.z = pk2(s[4 * 33], s[5 * 33]); o.w = pk2(s[6 * 33], s[7 * 33]);
        *(v4u*)(WT + (size_t)dst_row(mode, n0 + n) * K + k0 + 8 * c) = o; }
    asm volatile("s_waitcnt lgkmcnt(0)" ::: "memory");
}
__device__ __forceinline__ void prologue(const Args& a, LAS unsigned char* lds) {
    const int tid = tid_opaque(), lane = tid & 63, wave = tid >> 6; const int bid = bid_opaque();
    LAS float* scr = (LAS float*)(lds + wave * 16384);
    const int gw = bid * 8 + wave, NGW = gridDim.x * 8;
    unsigned char* ws = a.ws;
    for (int mi = 0; mi < 12; ++mi) {
        const float* W; bf16* WT; int K, N, mode;
        if (mi < 4) { W = a.w_in + (size_t)mi * DM * NUP; WT = (bf16*)(ws + WS_WIN) + (size_t)mi * NUP * DM; K = DM; N = NUP; mode = 1; }
        else if (mi < 8) { W = a.w_out + (size_t)(mi - 4) * FF * DM; WT = (bf16*)(ws + WS_WOUT) + (size_t)(mi - 4) * DM * FF; K = FF; N = DM; mode = 0; }
        else if (mi == 8) { W = a.sb_qkv; WT = (bf16*)(ws + WS_WQKV); K = DM; N = NQKV; mode = 0; }
        else if (mi == 9) { W = a.df_qkv; WT = (bf16*)(ws + WS_WQKV) + (size_t)NQKV * DM; K = DM; N = NQKV; mode = 2; }
        else if (mi == 10) { W = a.sb_o; WT = (bf16*)(ws + WS_WO); K = DM; N = DM; mode = 0; }
        else { W = a.df_o; WT = (bf16*)(ws + WS_WO) + (size_t)DM * DM; K = DM; N = DM; mode = 0; }
        const int nit = (K / 64) * (N / 32);
        for (int it = gw; it < nit; it += NGW) transpose_item(W, K, N, WT, mode, scr, it, lane);
    }
    float* ssq = (float*)(ws + WS_SSQ); bf16* XA = (bf16*)(ws + WS_XA);
    f32x4 gv[4];
#pragma unroll
    for (int j = 0; j < 4; ++j) gv[j] = *((const f32x4*)a.ng + lane + 64 * j);
    for (int m = gw; m < M; m += NGW) {
        const f32x4* xr = (const f32x4*)(a.x + (size_t)m * DM) + lane; f32x4 v[4]; float s = 0.f;
#pragma unroll
        for (int j = 0; j < 4; ++j) { v[j] = xr[64 * j]; s += (v[j][0] * v[j][0] + v[j][1] * v[j][1]) + (v[j][2] * v[j][2] + v[j][3] * v[j][3]); }
        s = wave_sum(s);
        if (lane == 0) ssq[m] = s;
        unsigned long long* o8 = (unsigned long long*)(XA + (size_t)m * DM) + lane;
#pragma unroll
        for (int j = 0; j < 4; ++j) { const f32x4 t = v[j] * gv[j]; o8[64 * j] = (unsigned long long)pk2(t[0], t[1]) | ((unsigned long long)pk2(t[2], t[3]) << 32); }
    }
    const int gt = bid * 512 + tid, NGT = gridDim.x * 512;
    for (int i = gt; i < 6 * M; i += NGT) ssq[M + i] = 0.f;
    float* rc = (float*)(ws + WS_ROPE); float* rsn = rc + 2048 * 32;
    for (int i = gt; i < 2048 * 32; i += NGT) { const int pos = i >> 5, fi = i & 31;
        const float inv = __builtin_amdgcn_exp2f(-(float)fi * (13.287712379549449f / 32.0f));
        const float ang = (float)pos * inv;
        const double rev = (double)ang * 0.15915494309189535; const float fr = (float)(rev - rint(rev));
        rc[i] = __builtin_amdgcn_cosf(fr); rsn[i] = __builtin_amdgcn_sinf(fr); }
}
__device__ __forceinline__ void final_norm(const Args& a) {
    const int tid = tid_opaque(), lane = tid & 63, wave = tid >> 6; const int bid = bid_opaque();
    const int gw = bid * 8 + wave, NGW = gridDim.x * 8;
    const float* ssq = (const float*)(a.ws + WS_SSQ) + 6 * M;
    f32x4 gv[4];
#pragma unroll
    for (int j = 0; j < 4; ++j) gv[j] = *((const f32x4*)a.fg + lane + 64 * j);
    for (int m = gw; m < M; m += NGW) { const float rs = pg8::rstd_of(ssq[m]); f32x4* xr = (f32x4*)(a.out + (size_t)m * DM) + lane;
#pragma unroll
        for (int j = 0; j < 4; ++j) xr[64 * j] = xr[64 * j] * rs * gv[j]; }
}

__device__ __forceinline__ void sb_attn_naive(const bf16* Q, const bf16* K, const bf16* V, bf16* O) {
    const int tidn = tid_opaque();
    for (int it = bid_opaque(); it < 512; it += gridDim.x) {
        const int bh = it & 127, qb = 3 - (it >> 7), b = bh >> 4, h = bh & 15;
        const int t = qb * 512 + tidn;
        const uint4* qp = (const uint4*)(Q + ((size_t)(b * SEQ + t)) * DM + h * 64);
        float q[64], o[64];
#pragma unroll
        for (int j = 0; j < 8; ++j) { const uint4 w = qp[j]; q[8 * j] = bflo(w.x); q[8 * j + 1] = bfhi(w.x); q[8 * j + 2] = bflo(w.y); q[8 * j + 3] = bfhi(w.y); q[8 * j + 4] = bflo(w.z); q[8 * j + 5] = bfhi(w.z); q[8 * j + 6] = bflo(w.w); q[8 * j + 7] = bfhi(w.w); }
#pragma unroll
        for (int d = 0; d < 64; ++d) o[d] = 0.f;
        float R = 0.f;
        for (int s = qb * 512 + 511; s >= 0; --s) {
            const uint4* kp = (const uint4*)(K + ((size_t)(b * SEQ + s)) * DM + h * 64);
            float z = 0.f;
#pragma unroll
            for (int j = 0; j < 8; ++j) { const uint4 w = kp[j]; z += q[8 * j] * bflo(w.x) + q[8 * j + 1] * bfhi(w.x) + q[8 * j + 2] * bflo(w.y) + q[8 * j + 3] * bfhi(w.y) + q[8 * j + 4] * bflo(w.z) + q[8 * j + 5] * bfhi(w.z) + q[8 * j + 6] * bflo(w.w) + q[8 * j + 7] * bfhi(w.w); }
            if (s < t) {
                const float sp = fmaxf(z, 0.f) + __builtin_amdgcn_logf(1.0f + __builtin_amdgcn_exp2f(-fabsf(z)));
                const float aw = __builtin_amdgcn_exp2f((z - sp) + R);
                R -= sp;
                const bf16* vp = V + ((size_t)(b * 1024 + h * 64)) * SEQ + s;
#pragma unroll
                for (int d = 0; d < 64; ++d) o[d] += aw * bflo((unsigned)vp[(size_t)d * SEQ]);
            }
        }
        uint4* op = (uint4*)(O + ((size_t)(b * SEQ + t)) * DM + h * 64);
#pragma unroll
        for (int j = 0; j < 8; ++j) { uint4 w; w.x = pk2(o[8 * j], o[8 * j + 1]); w.y = pk2(o[8 * j + 2], o[8 * j + 3]); w.z = pk2(o[8 * j + 4], o[8 * j + 5]); w.w = pk2(o[8 * j + 6], o[8 * j + 7]); op[j] = w; }
    }
}
__device__ __forceinline__ float diff_lambda(const float* lp) {
    float s1 = 0.f, s2 = 0.f;
    for (int i = 0; i < 64; ++i) { s1 += lp[i] * lp[64 + i]; s2 += lp[128 + i] * lp[192 + i]; }
    return expf(s1) - expf(s2) + LAMBDA_INIT;
}
__device__ __forceinline__ void diff_attn_naive(const bf16* Q, const bf16* K, const bf16* V, bf16* O, float* T, const float* lamp, const float* subg) {
    const float lam = diff_lambda(lamp);
    const int tidn = tid_opaque();
    for (int it = bid_opaque(); it < 256; it += gridDim.x) {
        const int bh = it & 63, qb = 3 - (it >> 6), b = bh >> 3, h = bh & 7;
        const int t = qb * 512 + tidn, kend = ((t >> 6) + 1) << 6;
        float* Tr = T + ((size_t)(b * SEQ + t)) * DM + h * 128;
        for (int vh = 0; vh < 2; ++vh)
            for (int mp = 0; mp < 2; ++mp) {
                const uint4* qp = (const uint4*)(Q + ((size_t)(b * SEQ + t)) * DM + (h * 2 + mp) * 64);
                float q[64], o[64];
#pragma unroll
                for (int j = 0; j < 8; ++j) { const uint4 w = qp[j]; q[8 * j] = bflo(w.x); q[8 * j + 1] = bfhi(w.x); q[8 * j + 2] = bflo(w.y); q[8 * j + 3] = bfhi(w.y); q[8 * j + 4] = bflo(w.z); q[8 * j + 5] = bfhi(w.z); q[8 * j + 6] = bflo(w.w); q[8 * j + 7] = bfhi(w.w); }
#pragma unroll
                for (int d = 0; d < 64; ++d) o[d] = 0.f;
                float mx = -1e30f, l = 0.f;
                for (int s = 0; s < qb * 512 + 512; ++s) {
                    const uint4* kp = (const uint4*)(K + ((size_t)(b * SEQ + s)) * DM + (h * 2 + mp) * 64);
                    float z = 0.f;
#pragma unroll
                    for (int j = 0; j < 8; ++j) { const uint4 w = kp[j]; z += q[8 * j] * bflo(w.x) + q[8 * j + 1] * bfhi(w.x) + q[8 * j + 2] * bflo(w.y) + q[8 * j + 3] * bfhi(w.y) + q[8 * j + 4] * bflo(w.z) + q[8 * j + 5] * bfhi(w.z) + q[8 * j + 6] * bflo(w.w) + q[8 * j + 7] * bfhi(w.w); }
                    if (s < kend) {
                        const float mn = fmaxf(mx, z), f = __builtin_amdgcn_exp2f(mx - mn), p = __builtin_amdgcn_exp2f(z - mn);
                        mx = mn; l = l * f + p;
                        const bf16* vp = V + ((size_t)(b * 1024 + h * 128 + vh * 64)) * SEQ + s;
#pragma unroll
                        for (int d = 0; d < 64; ++d) o[d] = o[d] * f + p * bflo((unsigned)vp[(size_t)d * SEQ]);
                    }
                }
                const float il = 1.0f / l;
                if (mp == 0) {
#pragma unroll
                    for (int d = 0; d < 64; d += 4) *(f32x4*)(Tr + vh * 64 + d) = (f32x4){o[d] * il, o[d + 1] * il, o[d + 2] * il, o[d + 3] * il};
                } else {
#pragma unroll
                    for (int d = 0; d < 64; d += 4) { const f32x4 p1 = *(const f32x4*)(Tr + vh * 64 + d);
                        *(f32x4*)(Tr + vh * 64 + d) = (f32x4){p1[0] - lam * o[d] * il, p1[1] - lam * o[d + 1] * il, p1[2] - lam * o[d + 2] * il, p1[3] - lam * o[d + 3] * il}; }
                }
            }
        float ss = 0.f;
        for (int d = 0; d < 128; d += 4) { const f32x4 v = *(const f32x4*)(Tr + d); ss += (v[0] * v[0] + v[1] * v[1]) + (v[2] * v[2] + v[3] * v[3]); }
        const float rs = (1.0f / sqrtf(ss * (1.0f / 128.0f) + 1e-6f)) * (1.0f - LAMBDA_INIT);
        bf16* Or = O + ((size_t)(b * SEQ + t)) * DM + h * 128;
        for (int d = 0; d < 128; d += 4) { const f32x4 v = *(const f32x4*)(Tr + d); const f32x4 g = *(const f32x4*)(subg + d);
            uint2 w; w.x = pk2(v[0] * rs * g[0], v[1] * rs * g[1]); w.y = pk2(v[2] * rs * g[2], v[3] * rs * g[3]); *(uint2*)(Or + d) = w; }
    }
}
typedef short a_bf16x8 __attribute__((ext_vector_type(8)));
typedef short a_s16x4 __attribute__((ext_vector_type(4)));
typedef _Float16 a_f16x8 __attribute__((ext_vector_type(8)));
typedef float a_f32x16 __attribute__((ext_vector_type(16)));
__device__ __forceinline__ int crow(int r, int hi) { return (r & 3) + 8 * (r >> 2) + 4 * hi; }
__device__ __forceinline__ unsigned a_cvtpk(float lo, float hi) { typedef float f2 __attribute__((ext_vector_type(2))); typedef __bf16 b2 __attribute__((ext_vector_type(2))); f2 v = {lo, hi}; b2 b = __builtin_convertvector(v, b2); return __builtin_bit_cast(unsigned, b); }
#define A_PACK_BF16(P0, P1, PW) do { \
    PW[0] = __builtin_bit_cast(a_bf16x8, (v4u){a_cvtpk(P0[0], P0[1]), a_cvtpk(P0[2], P0[3]), a_cvtpk(P0[4], P0[5]), a_cvtpk(P0[6], P0[7])}); \
    PW[1] = __builtin_bit_cast(a_bf16x8, (v4u){a_cvtpk(P0[8], P0[9]), a_cvtpk(P0[10], P0[11]), a_cvtpk(P0[12], P0[13]), a_cvtpk(P0[14], P0[15])}); \
    PW[2] = __builtin_bit_cast(a_bf16x8, (v4u){a_cvtpk(P1[0], P1[1]), a_cvtpk(P1[2], P1[3]), a_cvtpk(P1[4], P1[5]), a_cvtpk(P1[6], P1[7])}); \
    PW[3] = __builtin_bit_cast(a_bf16x8, (v4u){a_cvtpk(P1[8], P1[9]), a_cvtpk(P1[10], P1[11]), a_cvtpk(P1[12], P1[13]), a_cvtpk(P1[14], P1[15])}); } while (0)

__device__ __forceinline__ void sb_attn(const bf16* Q, const bf16* K, const bf16* VT, bf16* O, LAS unsigned char* lds) {
    const int tid = tid_opaque(), lane = tid & 63, r32 = lane & 31, hi = lane >> 5, wid = __builtin_amdgcn_readfirstlane(tid >> 6);
    const int c = bid_opaque(), G = gridDim.x;
    a_f16x8 TA0, TA1, ONES;
#pragma unroll
    for (int e = 0; e < 8; ++e) { const int kin = 4 * hi + (e & 3) + 8 * (e >> 2); TA0[e] = (kin > r32) ? (_Float16)1.0f : (_Float16)0.0f; TA1[e] = (16 + kin > r32) ? (_Float16)1.0f : (_Float16)0.0f; ONES[e] = (_Float16)1.0f; }
    for (int u = c; u < 1024; u += G) {
        const int cc = u & 255, ui = u >> 8, bh = cc >> 1, sg = cc & 1;
        const int qb = (ui == 0) ? 7 - sg : (ui == 1) ? sg : (ui == 2) ? 5 - sg : 2 + sg;
        const int b = bh >> 4, h = bh & 15;
        const int q0 = qb * 256 + wid * 32, td = q0 >> 6, Tmax = qb * 4 + 3, qloc = (q0 & 63) + r32;
        const bf16* Qw = Q + ((size_t)(b * SEQ + q0 + r32)) * DM + h * 64 + hi * 8;
        a_bf16x8 qr[4];
#pragma unroll
        for (int d0 = 0; d0 < 4; ++d0) qr[d0] = *(const a_bf16x8*)(Qw + d0 * 16);
        a_f32x16 ot[2]; ot[0] = (a_f32x16){}; ot[1] = (a_f32x16){};
        float R = 0.f;
        const bf16* kg = K + ((size_t)(b * SEQ + lane)) * DM + h * 64 + wid * 8;
        const bf16* vg = VT + ((size_t)(b * 1024 + h * 64 + lane)) * SEQ + wid * 8;
        v4u kreg = *(const v4u*)(kg + (size_t)Tmax * 64 * DM), vreg = *(const v4u*)(vg + Tmax * 64);
        for (int t = Tmax; t >= 0; --t) {
            LAS unsigned char* kb = lds + ((Tmax - t) & 1) * 16384; LAS unsigned char* vb = kb + 8192;
            *(LAS v4u*)(kb + wid * 1024 + lane * 16) = kreg; *(LAS v4u*)(vb + wid * 1024 + lane * 16) = vreg;
            if (t > 0) { kreg = *(const v4u*)(kg + (size_t)(t - 1) * 64 * DM); vreg = *(const v4u*)(vg + (t - 1) * 64); }
            __syncthreads();
            if (t <= td) {
                a_f32x16 p0 = (a_f32x16){}, p1 = (a_f32x16){};
#pragma unroll
                for (int d0 = 0; d0 < 4; ++d0) { const a_bf16x8 k0 = *(const LAS a_bf16x8*)(kb + (2 * d0 + hi) * 1024 + r32 * 16), k1 = *(const LAS a_bf16x8*)(kb + (2 * d0 + hi) * 1024 + 512 + r32 * 16);
                    p0 = __builtin_amdgcn_mfma_f32_32x32x16_bf16(k0, qr[d0], p0, 0, 0, 0); p1 = __builtin_amdgcn_mfma_f32_32x32x16_bf16(k1, qr[d0], p1, 0, 0, 0); }
                const bool diag = (t == td);
                float lv0[16], lv1[16];
#pragma unroll
                for (int r = 0; r < 16; ++r) {
                    { const float z = p0[r], uu = __builtin_amdgcn_logf(1.0f + __builtin_amdgcn_exp2f(-fabsf(z))); float sp = fmaxf(z, 0.f) + uu, ls = fminf(z, 0.f) - uu;
                      if (diag && crow(r, hi) >= qloc) { sp = 0.f; ls = -__builtin_inff(); } p0[r] = ls; lv0[r] = -sp; }
                    { const float z = p1[r], uu = __builtin_amdgcn_logf(1.0f + __builtin_amdgcn_exp2f(-fabsf(z))); float sp = fmaxf(z, 0.f) + uu, ls = fminf(z, 0.f) - uu;
                      if (diag && 32 + crow(r, hi) >= qloc) { sp = 0.f; ls = -__builtin_inff(); } p1[r] = ls; lv1[r] = -sp; }
                }
                a_f16x8 lw[4];
#pragma unroll
                for (int e = 0; e < 8; ++e) { lw[0][e] = (_Float16)lv0[e]; lw[1][e] = (_Float16)lv0[8 + e]; lw[2][e] = (_Float16)lv1[e]; lw[3][e] = (_Float16)lv1[8 + e]; }
                a_f32x16 s0, s1;
#pragma unroll
                for (int r = 0; r < 16; ++r) { s0[r] = R; s1[r] = R; }
                s0 = __builtin_amdgcn_mfma_f32_32x32x16_f16(TA0, lw[0], s0, 0, 0, 0); s0 = __builtin_amdgcn_mfma_f32_32x32x16_f16(TA1, lw[1], s0, 0, 0, 0);
                s0 = __builtin_amdgcn_mfma_f32_32x32x16_f16(ONES, lw[2], s0, 0, 0, 0); s0 = __builtin_amdgcn_mfma_f32_32x32x16_f16(ONES, lw[3], s0, 0, 0, 0);
                s1 = __builtin_amdgcn_mfma_f32_32x32x16_f16(TA0, lw[2], s1, 0, 0, 0); s1 = __builtin_amdgcn_mfma_f32_32x32x16_f16(TA1, lw[3], s1, 0, 0, 0);
                const float Rn = s0[0] + lv0[0];
                R = __shfl(Rn, r32);
#pragma unroll
                for (int r = 0; r < 16; ++r) { p0[r] = __builtin_amdgcn_exp2f(p0[r] + s0[r]); p1[r] = __builtin_amdgcn_exp2f(p1[r] + s1[r]); }
                a_bf16x8 pw[4]; A_PACK_BF16(p0, p1, pw);
#pragma unroll
                for (int blk = 0; blk < 2; ++blk)
#pragma unroll
                    for (int j = 0; j < 4; ++j) { const a_s16x4 lo = *(const LAS a_s16x4*)(vb + (2 * j) * 1024 + (32 * blk + r32) * 16 + 8 * hi), hh = *(const LAS a_s16x4*)(vb + (2 * j + 1) * 1024 + (32 * blk + r32) * 16 + 8 * hi);
                        const a_bf16x8 vf = (a_bf16x8){lo[0], lo[1], lo[2], lo[3], hh[0], hh[1], hh[2], hh[3]};
                        ot[blk] = __builtin_amdgcn_mfma_f32_32x32x16_bf16(vf, pw[j], ot[blk], 0, 0, 0); }
            }
        }
        bf16* Ow = O + ((size_t)(b * SEQ + q0 + r32)) * DM + h * 64 + 4 * hi;
#pragma unroll
        for (int blk = 0; blk < 2; ++blk)
#pragma unroll
            for (int g = 0; g < 4; ++g) { uint2 w; w.x = a_cvtpk(ot[blk][4 * g], ot[blk][4 * g + 1]); w.y = a_cvtpk(ot[blk][4 * g + 2], ot[blk][4 * g + 3]); *(uint2*)(Ow + 32 * blk + 8 * g) = w; }
    }
}

__device__ __forceinline__ void diff_attn(const bf16* Q, const bf16* K, const bf16* VT, bf16* O, const float* lamp, const float* subg, LAS unsigned char* lds) {
    const int tid = tid_opaque(), lane = tid & 63, r32 = lane & 31, hi = lane >> 5, wid = __builtin_amdgcn_readfirstlane(tid >> 6), mp = wid >> 2, w4 = wid & 3;
    const int c = bid_opaque(), G = gridDim.x;
    const float lam = diff_lambda(lamp);
    LAS float* ex = (LAS float*)(lds + 65536);
    for (int u = c; u < 1024; u += G) {
        const int cc = u & 255, ui = u >> 8, bh = cc >> 2, sg = cc & 3;
        const int qb = (ui == 0) ? 15 - sg : (ui == 1) ? 8 + sg : (ui == 2) ? 7 - sg : sg;
        const int b = bh >> 3, h = bh & 7;
        const int q0 = qb * 128 + w4 * 32, tdw = q0 >> 6, Tmax = qb * 2 + 1;
        const bf16* Qw = Q + ((size_t)(b * SEQ + q0 + r32)) * DM + (h * 2 + mp) * 64 + hi * 8;
        a_bf16x8 qr[4];
#pragma unroll
        for (int d0 = 0; d0 < 4; ++d0) qr[d0] = *(const a_bf16x8*)(Qw + d0 * 16);
        a_f32x16 ot[4];
#pragma unroll
        for (int i = 0; i < 4; ++i) ot[i] = (a_f32x16){};
        float mx = -1e30f, l = 0.f;
        const bf16* kg = K + ((size_t)(b * SEQ + lane)) * DM + h * 128 + wid * 8;
        const bf16* vg = VT + ((size_t)(b * 1024 + h * 128 + lane)) * SEQ + wid * 8;
        v4u k1r = *(const v4u*)(kg), k2r = *(const v4u*)(kg + 64), v1r = *(const v4u*)(vg), v2r = *(const v4u*)(vg + 64 * SEQ);
        for (int t = 0; t <= Tmax; ++t) {
            LAS unsigned char* base = lds + (t & 1) * 32768;
            *(LAS v4u*)(base + wid * 1024 + lane * 16) = k1r; *(LAS v4u*)(base + 8192 + wid * 1024 + lane * 16) = k2r;
            *(LAS v4u*)(base + 16384 + wid * 2048 + lane * 16) = v1r; *(LAS v4u*)(base + 16384 + wid * 2048 + (lane + 64) * 16) = v2r;
            if (t < Tmax) { const size_t ko = (size_t)(t + 1) * 64 * DM; const int vo = (t + 1) * 64;
                k1r = *(const v4u*)(kg + ko); k2r = *(const v4u*)(kg + ko + 64); v1r = *(const v4u*)(vg + vo); v2r = *(const v4u*)(vg + vo + 64 * SEQ); }
            __syncthreads();
            if (t <= tdw) {
                LAS unsigned char* kb = base + mp * 8192; LAS unsigned char* vb = base + 16384;
                a_f32x16 p0 = (a_f32x16){}, p1 = (a_f32x16){};
#pragma unroll
                for (int d0 = 0; d0 < 4; ++d0) { const a_bf16x8 k0 = *(const LAS a_bf16x8*)(kb + (2 * d0 + hi) * 1024 + r32 * 16), k1 = *(const LAS a_bf16x8*)(kb + (2 * d0 + hi) * 1024 + 512 + r32 * 16);
                    p0 = __builtin_amdgcn_mfma_f32_32x32x16_bf16(k0, qr[d0], p0, 0, 0, 0); p1 = __builtin_amdgcn_mfma_f32_32x32x16_bf16(k1, qr[d0], p1, 0, 0, 0); }
                float rm = fmaxf(p0[0], p1[0]);
#pragma unroll
                for (int r = 1; r < 16; ++r) rm = fmaxf(rm, fmaxf(p0[r], p1[r]));
                rm = fmaxf(rm, __shfl_xor(rm, 32));
                if (__any(rm > mx)) { const float mn = fmaxf(mx, rm), f = __builtin_amdgcn_exp2f(mx - mn); mx = mn; l *= f;
#pragma unroll
                    for (int i = 0; i < 4; ++i) ot[i] = ot[i] * f; }
                float ps = 0.f;
#pragma unroll
                for (int r = 0; r < 16; ++r) { p0[r] = __builtin_amdgcn_exp2f(p0[r] - mx); p1[r] = __builtin_amdgcn_exp2f(p1[r] - mx); ps += p0[r] + p1[r]; }
                l += ps;
                a_bf16x8 pw[4]; A_PACK_BF16(p0, p1, pw);
#pragma unroll
                for (int blk = 0; blk < 4; ++blk)
#pragma unroll
                    for (int j = 0; j < 4; ++j) { const a_s16x4 lo = *(const LAS a_s16x4*)(vb + (2 * j) * 2048 + (32 * blk + r32) * 16 + 8 * hi), hh = *(const LAS a_s16x4*)(vb + (2 * j + 1) * 2048 + (32 * blk + r32) * 16 + 8 * hi);
                        const a_bf16x8 vf = (a_bf16x8){lo[0], lo[1], lo[2], lo[3], hh[0], hh[1], hh[2], hh[3]};
                        ot[blk] = __builtin_amdgcn_mfma_f32_32x32x16_bf16(vf, pw[j], ot[blk], 0, 0, 0); }
            }
        }
        const float il = 1.0f / (l + __shfl_xor(l, 32));
        if (mp == 1) {
#pragma unroll
            for (int blk = 0; blk < 4; ++blk)
#pragma unroll
                for (int r = 0; r < 16; ++r) ex[((w4 * 4 + blk) * 16 + r) * 64 + lane] = ot[blk][r] * il;
        }
        __syncthreads();
        if (mp == 0) {
            float ss = 0.f;
#pragma unroll
            for (int blk = 0; blk < 4; ++blk)
#pragma unroll
                for (int r = 0; r < 16; ++r) { const float o = ot[blk][r] * il - lam * ex[((w4 * 4 + blk) * 16 + r) * 64 + lane]; ot[blk][r] = o; ss += o * o; }
            ss += __shfl_xor(ss, 32);
            const float rs = (1.0f / sqrtf(ss * (1.0f / 128.0f) + 1e-6f)) * (1.0f - LAMBDA_INIT);
            bf16* Ow = O + ((size_t)(b * SEQ + q0 + r32)) * DM + h * 128 + 4 * hi;
#pragma unroll
            for (int blk = 0; blk < 4; ++blk)
#pragma unroll
                for (int g = 0; g < 4; ++g) { const f32x4 gg = *(const f32x4*)(subg + 32 * blk + 8 * g + 4 * hi);
                    uint2 w; w.x = a_cvtpk(ot[blk][4 * g] * rs * gg[0], ot[blk][4 * g + 1] * rs * gg[1]); w.y = a_cvtpk(ot[blk][4 * g + 2] * rs * gg[2], ot[blk][4 * g + 3] * rs * gg[3]);
                    *(uint2*)(Ow + 32 * blk + 8 * g) = w; }
        }
    }
}
#ifndef MK_MULTI
#define MK_MULTI 0
#endif
__global__ void __launch_bounds__(512, 2) mega(Args a_in) {
    extern __shared__ __attribute__((aligned(16))) unsigned char lds_raw[];
    LAS unsigned char* lds = (LAS unsigned char*)lds_raw;
    cg::grid_group grid = cg::this_grid();
    const int ph_lo = a_in.ph_lo, ph_hi = a_in.ph_hi;
    for (int p = ph_lo; p < ph_hi; ++p) {
#if defined(MK_REREAD)

    unsigned long long apv = (unsigned long long)__builtin_amdgcn_kernarg_segment_ptr();
    unsigned aplo = (unsigned)apv, aphi = (unsigned)(apv >> 32); asm volatile("" : "+s"(aplo), "+s"(aphi));
    aplo = __builtin_amdgcn_readfirstlane(aplo); aphi = __builtin_amdgcn_readfirstlane(aphi);
    const __attribute__((address_space(4))) unsigned char* ap = (const __attribute__((address_space(4))) unsigned char*)(((unsigned long long)aphi << 32) | aplo);
    Args a; __builtin_memcpy(&a, ap, sizeof(Args));
#else
    const Args a = a_in;
#endif
    unsigned char* ws = a.ws;
    float* ssq = (float*)(ws + WS_SSQ);
    bf16* XA = (bf16*)(ws + WS_XA); bf16* H = (bf16*)(ws + WS_H); bf16* Q = (bf16*)(ws + WS_Q); bf16* Kb = (bf16*)(ws + WS_K); bf16* Vb = (bf16*)(ws + WS_V); bf16* O = (bf16*)(ws + WS_O);
    const bf16* Win = (const bf16*)(ws + WS_WIN); const bf16* Wout = (const bf16*)(ws + WS_WOUT); const bf16* Wqkv = (const bf16*)(ws + WS_WQKV); const bf16* Wo = (const bf16*)(ws + WS_WO);
    const int G = gridDim.x, c = bid_opaque();
    {
        if (p == 0) {
#ifndef NO_PRO
 prologue(a, lds);
#endif
 }
        else if (p == NPHASE - 1) final_norm(a);
        else {
            const int L = (p - 1) / 7, s = (p - 1) % 7;
            if (s == 0 || s == 5) {
                const int ab = (s == 5) ? 1 : 0;
                pg8::Gemm g{XA, Win + (size_t)(L * 2 + ab) * NUP * DM, M, NUP, DM}; pg8::StaticOrder S; S.init(M, NUP, G, c);
                pg8::EpiSwiglu E{H, ssq + (size_t)(3 * L + 2 * ab) * M, FF};

#ifndef NO_UP
 pg8::gemm_phase<pg8::EpiSwiglu, pg8::StaticOrder, true, true>(lds, g, S, E);
#endif

            } else if (s == 1 || s == 4 || s == 6) {
                const bf16* A; const bf16* Bt; int K; float alpha; int nn; const float* gain;
                if (s == 4) { A = O; Bt = Wo + (size_t)L * DM * DM; K = DM; alpha = 1.0f; nn = 3 * L + 2; gain = a.ng + (size_t)(3 * L + 2) * DM; }
                else if (s == 1) { A = H; Bt = Wout + (size_t)(L * 2) * DM * FF; K = FF; alpha = 0.5f; nn = 3 * L + 1; gain = a.ng + (size_t)(3 * L + 1) * DM; }
                else { A = H; Bt = Wout + (size_t)(L * 2 + 1) * DM * FF; K = FF; alpha = 0.5f; nn = 3 * L + 3; gain = (L == 1) ? a.fg : a.ng + (size_t)(3 * L + 3) * DM; }
                pg8::Gemm g{A, Bt, M, DM, K}; pg8::StaticOrder S; S.init(M, DM, G, c);
                pg8::EpiRes E{(p == 2) ? a.x : a.out, a.out, XA, gain, ssq + (size_t)nn * M, alpha};

#ifndef NO_RES
 pg8::gemm_phase<pg8::EpiRes, pg8::StaticOrder, true, true>(lds, g, S, E);
#endif

            } else if (s == 2) {
                pg8::Gemm g{XA, Wqkv + (size_t)L * NQKV * DM, M, NQKV, DM}; pg8::StaticOrder S; S.init(M, NQKV, G, c);
                const float* rc = (const float*)(ws + WS_ROPE);
                pg8::EpiQKV E{Q, (size_t)(WS_K - WS_Q) / 2, ssq + (size_t)(3 * L + 1) * M, QSCALE, L == 1 ? rc : nullptr, rc + 2048 * 32};

#ifndef NO_QKV
 pg8::gemm_phase<pg8::EpiQKV, pg8::StaticOrder, true, true>(lds, g, S, E);
#endif

            } else {

#if defined(SB_NAIVE)
                if (L == 0) sb_attn_naive(Q, Kb, Vb, O);
#else
                if (L == 0) sb_attn(Q, Kb, Vb, O, lds);
#endif
#if defined(DF_NAIVE)
                if (L == 1) diff_attn_naive(Q, Kb, Vb, O, (float*)(ws + WS_T), a.df_lam, a.df_sub);
#else
                if (L == 1) diff_attn(Q, Kb, Vb, O, a.df_lam, a.df_sub, lds);
#endif

            }
        }
        if (p + 1 < ph_hi) grid.sync();
    }
    }
}

extern "C" void kernel_launch(void* const* d_in, const int* in_sizes, int n_in, void* d_out, int out_size, void* d_ws, size_t ws_size, hipStream_t stream) {
    static int grid = 0;
    if (grid == 0) {
        if (n_in != 11 || in_sizes[0] != M * DM || out_size != M * DM || ws_size < WS_END) { fprintf(stderr, "kernel_launch: unexpected shapes (n_in %d, in0 %d, out %d, ws %zu)\n", n_in, n_in > 0 ? in_sizes[0] : -1, out_size, ws_size); grid = -1; return; }
        int dev = 0, cus = 0, per_cu = 0;
        if (hipGetDevice(&dev) != hipSuccess || hipDeviceGetAttribute(&cus, hipDeviceAttributeMultiprocessorCount, dev) != hipSuccess) { grid = -1; return; }
        if (hipFuncSetAttribute((const void*)mega, hipFuncAttributeMaxDynamicSharedMemorySize, LDS_BYTES) != hipSuccess) { fprintf(stderr, "kernel_launch: hipFuncSetAttribute failed\n"); grid = -1; return; }
        if (hipOccupancyMaxActiveBlocksPerMultiprocessor(&per_cu, (const void*)mega, 512, LDS_BYTES) != hipSuccess || per_cu < 1) { fprintf(stderr, "kernel_launch: occupancy query gave %d\n", per_cu); per_cu = 1; }
        (void)hipGetLastError();
        grid = cus * (per_cu > 1 ? 1 : per_cu);
    }
    if (grid < 0) return;
    Args a{};
    a.x = (const float*)d_in[0]; a.ng = (const float*)d_in[1]; a.fg = (const float*)d_in[2]; a.w_in = (const float*)d_in[3]; a.w_out = (const float*)d_in[4];
    a.sb_qkv = (const float*)d_in[5]; a.sb_o = (const float*)d_in[6]; a.df_qkv = (const float*)d_in[7]; a.df_o = (const float*)d_in[8]; a.df_lam = (const float*)d_in[9]; a.df_sub = (const float*)d_in[10];
    a.out = (float*)d_out; a.ws = (unsigned char*)d_ws;
#if MK_MULTI
    for (int p = 0; p < NPHASE; ++p) { a.ph_lo = p; a.ph_hi = p + 1; hipLaunchKernelGGL(mega, dim3(grid), dim3(512), LDS_BYTES, stream, a); }
#else
    a.ph_lo = 0; a.ph_hi = NPHASE;
    void* args[] = {&a};
    hipError_t e = hipLaunchCooperativeKernel((const void*)mega, dim3(grid), dim3(512), args, LDS_BYTES, stream);
    if (e != hipSuccess) fprintf(stderr, "cooperative launch failed: %s (grid %d)\n", hipGetErrorString(e), grid);
#endif
}
```

```cpp
#include <hip/hip_runtime.h>
#include <hip/hip_cooperative_groups.h>
#include <cstdio>
#include <cstdint>
namespace cg = cooperative_groups;
namespace pg8 {
#define PG8_LAS __attribute__((address_space(3)))
typedef unsigned short bf16_t;
typedef short bf16x8 __attribute__((ext_vector_type(8)));
typedef float f32x4 __attribute__((ext_vector_type(4)));
typedef unsigned u32x4 __attribute__((ext_vector_type(4)));
constexpr int BM = 256, BK = 64, HALF = 128, HTB = HALF * BK * 2  , STAGE_BYTES = 8 * HTB, NXCD = 8, WGM = 8;

__host__ __device__ __forceinline__ int lds_byte(int r, int c) { const int st = (r >> 4) * 2 + (c >> 5), rr = r & 15, cc = c & 31, ob = rr * 64 + cc * 2; return st * 1024 + (ob ^ (((ob >> 9) & 1) << 5)); }
__host__ __device__ __forceinline__ void stage_rc(int b, int& R, int& C) { const int st = b / 1024, sb = b % 1024, swz = sb ^ (((sb >> 9) & 1) << 5); R = (st >> 1) * 16 + swz / 64; C = (st & 1) * 32 + (swz % 64) / 2; }
__host__ __device__ __forceinline__ int perm32(int rho) { const int n = rho >> 4, i = rho & 15; return 8 * (i >> 2) + 4 * n + (i & 3); }

struct Unit { int pm, pn; };
struct Gemm { const bf16_t* A; const bf16_t* Bt; int M, N, K; };

struct StaticOrder {
    int nM, nN, nwg, G, c;
    __host__ __device__ void init(int M, int N, int G_, int c_) { nM = M / BM; nN = N / BM; nwg = nM * nN; G = G_; c = c_; }
    __host__ __device__ bool next(int i, Unit& u) const {
        const long L = (long)i * G + c; if (L >= nwg) return false;
        int wgid = (int)L; { const int q = nwg / NXCD, r = nwg % NXCD, xcd = wgid % NXCD, off = wgid / NXCD; wgid = (xcd < r ? xcd * (q + 1) : r * (q + 1) + (xcd - r) * q) + off; }
        const int nig = WGM * nN, gid = wgid / nig, fm = gid * WGM, gsz = (nM - fm) < WGM ? (nM - fm) : WGM;
        u.pm = fm + ((wgid % nig) % gsz); u.pn = (wgid % nig) / gsz; return true;
    }
    __device__ __forceinline__ void a_ready(const Unit&) const {}
    __device__ __forceinline__ void done(const Unit&) const {}
};
__device__ __forceinline__ unsigned cvt_pk_bf16(float lo, float hi) { unsigned r; asm volatile("v_cvt_pk_bf16_f32 %0, %1, %2" : "=v"(r) : "v"(lo), "v"(hi)); return r; }
typedef float f32x2 __attribute__((ext_vector_type(2)));
__device__ __forceinline__ float rstd_of(float ssq) { return 1.0f / sqrtf(ssq * (1.0f / 1024.0f) + 1e-6f); }
struct EpiSwiglu {
    static constexpr bool PERM = true, AFTER_DRAIN = false;
    bf16_t* H; const float* ssq; int ldh;
    __device__ __forceinline__ void operator()(const f32x4 (&acc)[2][2][4][2], const Unit& u, int wr, int wc, int fr, int fq) const {
        const int row0 = u.pm * BM + wr * 64 + fr, hcol = u.pn * HALF + wc * 32 + 8 * fq;
#pragma unroll
        for (int ai = 0; ai < 2; ++ai)
#pragma unroll
            for (int m = 0; m < 4; ++m) { const int row = row0 + ai * HALF + m * 16; const float rs = rstd_of(ssq[row]);
                float hv[8];
#pragma unroll
                for (int n = 0; n < 2; ++n)
#pragma unroll
                    for (int e = 0; e < 4; ++e) { const float g = acc[ai][0][m][n][e] * rs, up = acc[ai][1][m][n][e] * rs;
                        const float ex = __builtin_amdgcn_exp2f(-g * 1.4426950408889634f);
                        hv[n * 4 + e] = g * up * __builtin_amdgcn_rcpf(1.0f + ex); }
                u32x4 w; w.x = cvt_pk_bf16(hv[0], hv[1]); w.y = cvt_pk_bf16(hv[2], hv[3]); w.z = cvt_pk_bf16(hv[4], hv[5]); w.w = cvt_pk_bf16(hv[6], hv[7]);
                *(u32x4*)(H + (size_t)row * ldh + hcol) = w; }
    }
};
struct EpiRes {
    static constexpr bool PERM = true, AFTER_DRAIN = false;
    const float* base; float* out; bf16_t* xa; const float* gain; float* ssq; float alpha;
    __device__ __forceinline__ void operator()(const f32x4 (&acc)[2][2][4][2], const Unit& u, int wr, int wc, int fr, int fq) const {
        const int row0 = u.pm * BM + wr * 64 + fr, col0 = u.pn * BM + wc * 32 + 8 * fq;
        f32x4 gv[2][2];
#pragma unroll
        for (int bj = 0; bj < 2; ++bj)
#pragma unroll
            for (int n = 0; n < 2; ++n) gv[bj][n] = *(const f32x4*)(gain + col0 + bj * HALF + 4 * n);
#pragma unroll
        for (int ai = 0; ai < 2; ++ai)
#pragma unroll
            for (int m = 0; m < 4; ++m) { const int row = row0 + ai * HALF + m * 16; float s = 0.f;
#pragma unroll
                for (int bj = 0; bj < 2; ++bj) { const size_t off = (size_t)row * 1024 + col0 + bj * HALF;
                    const f32x4 b0 = *(const f32x4*)(base + off), b1 = *(const f32x4*)(base + off + 4);
                    const f32x4 v0 = b0 + acc[ai][bj][m][0] * alpha, v1 = b1 + acc[ai][bj][m][1] * alpha;
                    *(f32x4*)(out + off) = v0; *(f32x4*)(out + off + 4) = v1;
                    s += (v0[0] * v0[0] + v0[1] * v0[1]) + (v0[2] * v0[2] + v0[3] * v0[3]) + (v1[0] * v1[0] + v1[1] * v1[1]) + (v1[2] * v1[2] + v1[3] * v1[3]);
                    const f32x4 a0 = v0 * gv[bj][0], a1 = v1 * gv[bj][1];
                    u32x4 w; w.x = cvt_pk_bf16(a0[0], a0[1]); w.y = cvt_pk_bf16(a0[2], a0[3]); w.z = cvt_pk_bf16(a1[0], a1[1]); w.w = cvt_pk_bf16(a1[2], a1[3]);
                    *(u32x4*)(xa + off) = w; }
                s += __shfl_xor(s, 16); s += __shfl_xor(s, 32);
                if (fq == 0) __hip_atomic_fetch_add(ssq + row, s, __ATOMIC_RELAXED, __HIP_MEMORY_SCOPE_AGENT); }
    }
};
struct EpiQKV {
    static constexpr bool PERM = true, AFTER_DRAIN = false;
    bf16_t* O; size_t stride; const float* ssq; float qscale; const float* rcos; const float* rsin;
    __device__ __forceinline__ void operator()(const f32x4 (&acc)[2][2][4][2], const Unit& u, int wr, int wc, int fr, int fq) const {
        const int t = u.pn >> 2, colt = (u.pn & 3) * BM;
        bf16_t* basep = O + (size_t)t * stride;
        const int row0 = u.pm * BM + wr * 64 + fr, col0 = colt + wc * 32 + 8 * fq;
        const float sc0 = (t == 0) ? qscale : 1.0f;
        const bool dorope = (rcos != nullptr) && (t < 2);
        const int pr0 = (wc & 1) * 16 + 4 * fq;
        if (t == 2) {
#pragma unroll
            for (int ai = 0; ai < 2; ++ai)
#pragma unroll
                for (int m = 0; m < 4; ++m) { const int row = row0 + ai * HALF + m * 16; const float sc = rstd_of(ssq[row]);
                    bf16_t* vp = basep + ((size_t)((row >> 11) * 1024 + col0)) * 2048 + (row & 2047);
#pragma unroll
                    for (int bj = 0; bj < 2; ++bj)
#pragma unroll
                        for (int n = 0; n < 2; ++n)
#pragma unroll
                            for (int e = 0; e < 4; ++e) { const unsigned w = cvt_pk_bf16(acc[ai][bj][m][n][e] * sc, 0.f); vp[(size_t)(bj * HALF + n * 4 + e) * 2048] = (bf16_t)w; } }
            return;
        }
#pragma unroll
        for (int ai = 0; ai < 2; ++ai)
#pragma unroll
            for (int m = 0; m < 4; ++m) { const int row = row0 + ai * HALF + m * 16; const float sc = rstd_of(ssq[row]) * sc0;
                f32x4 cs = (f32x4){1.f, 1.f, 1.f, 1.f}, sn = (f32x4){0.f, 0.f, 0.f, 0.f};
                if (dorope) { const int pos = row & 2047; cs = *(const f32x4*)(rcos + pos * 32 + pr0); sn = *(const f32x4*)(rsin + pos * 32 + pr0); }
#pragma unroll
                for (int bj = 0; bj < 2; ++bj) { const f32x4 v0 = acc[ai][bj][m][0] * sc, v1 = acc[ai][bj][m][1] * sc;
                    float o[8];
                    o[0] = v0[0] * cs[0] - v0[1] * sn[0]; o[1] = v0[1] * cs[0] + v0[0] * sn[0];
                    o[2] = v0[2] * cs[1] - v0[3] * sn[1]; o[3] = v0[3] * cs[1] + v0[2] * sn[1];
                    o[4] = v1[0] * cs[2] - v1[1] * sn[2]; o[5] = v1[1] * cs[2] + v1[0] * sn[2];
                    o[6] = v1[2] * cs[3] - v1[3] * sn[3]; o[7] = v1[3] * cs[3] + v1[2] * sn[3];
                    u32x4 w; w.x = cvt_pk_bf16(o[0], o[1]); w.y = cvt_pk_bf16(o[2], o[3]); w.z = cvt_pk_bf16(o[4], o[5]); w.w = cvt_pk_bf16(o[6], o[7]);
                    *(u32x4*)(basep + (size_t)row * 1024 + col0 + bj * HALF) = w; } }
    }
};
template <class Epi, class Sched, bool ALIGN_EPI = false, bool SP2 = false>
__device__ __forceinline__ void gemm_phase(PG8_LAS unsigned char* lds, const Gemm g, const Sched& S, const Epi& E) {
    int tid_ = threadIdx.x; asm volatile("" : "+v"(tid_));
    const int tid = tid_, wid = __builtin_amdgcn_readfirstlane(tid >> 6), lane = tid & 63, wr = wid >> 2, wc = wid & 3, fr = lane & 15, fq = lane >> 4;
    const int K = g.K, nt = K / BK;
    unsigned voffA[2], voffB[2];
#pragma unroll
    for (int i = 0; i < 2; ++i) { int R, C; stage_rc(tid * 16 + i * 8192, R, C); const int Rb = Epi::PERM ? ((R & ~31) + perm32(R & 31)) : R;
        voffA[i] = (unsigned)(R * K + C) * 2u; voffB[i] = (unsigned)(Rb * K + C) * 2u; }
    const size_t kstep = (size_t)(BK * 2);
    const size_t hstep = (size_t)HALF * K * 2;
    const size_t tstep = 2 * hstep;
    const unsigned ldsw = (unsigned)wid * 1024u;
    const int aoff = lds_byte(wr * 64 + fr, fq * 8), boff = lds_byte(wc * 32 + fr, fq * 8);
#define PG8_SA(b, h) (((b) * 2 + (h)) * HTB)
#define PG8_SB(b, h) ((4 + (b) * 2 + (h)) * HTB)
#define PG8_STAGE(bufoff, gbase, voff) do { _Pragma("unroll") for (int _i = 0; _i < 2; ++_i) \
        __builtin_amdgcn_global_load_lds((const unsigned*)((const char*)(gbase) + (voff)[_i]), (PG8_LAS unsigned*)(lds + (bufoff) + ldsw + _i * 8192), 16, 0, 0); } while (0)
#define PG8_LDA(dst, b, h) do { _Pragma("unroll") for (int m = 0; m < 4; ++m) _Pragma("unroll") for (int k = 0; k < 2; ++k) dst[m][k] = *(const PG8_LAS bf16x8*)(lds + PG8_SA(b, h) + aoff + m * 2048 + k * 1024); } while (0)
#define PG8_LDB(dst, b, h) do { _Pragma("unroll") for (int n = 0; n < 2; ++n) _Pragma("unroll") for (int k = 0; k < 2; ++k) dst[n][k] = *(const PG8_LAS bf16x8*)(lds + PG8_SB(b, h) + boff + n * 2048 + k * 1024); } while (0)
#define PG8_MMA(ai, bj, At, Bt) do { __builtin_amdgcn_s_setprio(1); _Pragma("unroll") for (int m = 0; m < 4; ++m) _Pragma("unroll") for (int n = 0; n < 2; ++n) _Pragma("unroll") for (int k = 0; k < 2; ++k) \
        acc[ai][bj][m][n] = __builtin_amdgcn_mfma_f32_16x16x32_bf16(Bt[n][k], At[m][k], acc[ai][bj][m][n], 0, 0, 0); __builtin_amdgcn_s_setprio(0); } while (0)
#define PG8_WAIT_V(n) asm volatile("s_waitcnt vmcnt(" #n ")" ::: "memory")
#define PG8_WAIT_L(n) asm volatile("s_waitcnt lgkmcnt(" #n ")" ::: "memory")
#define PG8_BAR __builtin_amdgcn_s_barrier()
#define PG8_SCHED __builtin_amdgcn_sched_barrier(0)
    Unit cur, nxt; int ui = 0;
    if (!S.next(0, cur)) return;
    f32x4 acc[2][2][4][2];
#pragma unroll
    for (int a = 0; a < 2; ++a)
#pragma unroll
        for (int b = 0; b < 2; ++b)
#pragma unroll
            for (int m = 0; m < 4; ++m)
#pragma unroll
                for (int n = 0; n < 2; ++n) acc[a][b][m][n] = (f32x4){0.f, 0.f, 0.f, 0.f};
    bf16x8 At[4][2], B0[2][2], B1[2][2];
    const char* cA = (const char*)g.A + (size_t)cur.pm * tstep; const char* cB = (const char*)g.Bt + (size_t)cur.pn * tstep;
    S.a_ready(cur);
    if constexpr (SP2) {
        PG8_STAGE(PG8_SB(0, 0), cB, voffB); PG8_STAGE(PG8_SB(0, 1), cB + hstep, voffB); PG8_STAGE(PG8_SA(0, 0), cA, voffA); PG8_STAGE(PG8_SA(0, 1), cA + hstep, voffA);
        if (wr == 1) PG8_BAR;
        PG8_WAIT_V(2); PG8_BAR;
        PG8_STAGE(PG8_SB(1, 0), cB + kstep, voffB); PG8_STAGE(PG8_SA(1, 0), cA + kstep, voffA); PG8_STAGE(PG8_SB(1, 1), cB + hstep + kstep, voffB);
        PG8_WAIT_V(6); PG8_BAR;
    } else {
        PG8_STAGE(PG8_SB(0, 0), cB, voffB); PG8_STAGE(PG8_SA(0, 0), cA, voffA); PG8_STAGE(PG8_SB(0, 1), cB + hstep, voffB); PG8_STAGE(PG8_SA(0, 1), cA + hstep, voffA);
        if (wr == 1) PG8_BAR;
        PG8_WAIT_V(4); PG8_BAR;
        PG8_STAGE(PG8_SB(1, 0), cB + kstep, voffB); PG8_STAGE(PG8_SA(1, 0), cA + kstep, voffA); PG8_STAGE(PG8_SB(1, 1), cB + hstep + kstep, voffB);
        PG8_WAIT_V(6); PG8_BAR;
    }
    for (;;) {
        const bool has_next = S.next(ui + 1, nxt);
        const char* nA = has_next ? (const char*)g.A + (size_t)nxt.pm * tstep : cA; const char* nB = has_next ? (const char*)g.Bt + (size_t)nxt.pn * tstep : cB;
        for (int t = 0; t < nt; t += 2) {
            const bool last = (t == nt - 2);
            const char* a1 = cA + (size_t)(t + 1) * kstep;
            const char* a2 = last ? nA : cA + (size_t)(t + 2) * kstep; const char* b2 = last ? nB : cB + (size_t)(t + 2) * kstep;
            const char* a3 = a2 + kstep; const char* b3 = b2 + kstep;
            if (last && has_next) S.a_ready(nxt);
            if constexpr (SP2) {
            PG8_LDB(B0, 0, 0); PG8_LDB(B1, 0, 1); PG8_SCHED; PG8_LDA(At, 0, 0); PG8_STAGE(PG8_SA(1, 1), a1 + hstep, voffA);
            PG8_WAIT_V(8); PG8_WAIT_L(0); PG8_BAR; PG8_MMA(0, 0, At, B0); PG8_MMA(0, 1, At, B1); PG8_BAR; PG8_SCHED;
            PG8_LDA(At, 0, 1); PG8_STAGE(PG8_SB(0, 0), b2, voffB); PG8_STAGE(PG8_SB(0, 1), b2 + hstep, voffB); PG8_STAGE(PG8_SA(0, 0), a2, voffA);
            PG8_WAIT_V(8); PG8_WAIT_L(0); PG8_BAR; PG8_MMA(1, 0, At, B0); PG8_MMA(1, 1, At, B1); PG8_BAR; PG8_SCHED;
            PG8_LDB(B0, 1, 0); PG8_LDB(B1, 1, 1); PG8_SCHED; PG8_LDA(At, 1, 0); PG8_STAGE(PG8_SA(0, 1), a2 + hstep, voffA);
            PG8_WAIT_V(8); PG8_WAIT_L(0); PG8_BAR; PG8_MMA(0, 0, At, B0); PG8_MMA(0, 1, At, B1); PG8_BAR; PG8_SCHED;
            PG8_LDA(At, 1, 1); PG8_STAGE(PG8_SB(1, 0), b3, voffB); PG8_STAGE(PG8_SB(1, 1), b3 + hstep, voffB); PG8_STAGE(PG8_SA(1, 0), a3, voffA);
            PG8_WAIT_V(8); PG8_WAIT_L(0); PG8_BAR; PG8_MMA(1, 0, At, B0); PG8_MMA(1, 1, At, B1); PG8_BAR; PG8_SCHED;
            } else {
            PG8_LDB(B0, 0, 0); PG8_SCHED; PG8_LDA(At, 0, 0); PG8_STAGE(PG8_SA(1, 1), a1 + hstep, voffA);
            PG8_WAIT_L(8); PG8_BAR; PG8_WAIT_L(0); PG8_MMA(0, 0, At, B0); PG8_BAR; PG8_SCHED;
            PG8_LDB(B1, 0, 1); PG8_STAGE(PG8_SB(0, 0), b2, voffB);
            PG8_BAR; PG8_WAIT_L(0); PG8_MMA(0, 1, At, B1); PG8_BAR;
            PG8_LDA(At, 0, 1); PG8_STAGE(PG8_SA(0, 0), a2, voffA);
            PG8_BAR; PG8_WAIT_L(0); PG8_MMA(1, 0, At, B0); PG8_BAR; PG8_SCHED;
            PG8_STAGE(PG8_SB(0, 1), b2 + hstep, voffB);
            PG8_WAIT_V(6); PG8_BAR; PG8_MMA(1, 1, At, B1); PG8_BAR;
            PG8_LDB(B0, 1, 0); PG8_SCHED; PG8_LDA(At, 1, 0); PG8_STAGE(PG8_SA(0, 1), a2 + hstep, voffA);
            PG8_WAIT_L(8); PG8_BAR; PG8_WAIT_L(0); PG8_MMA(0, 0, At, B0); PG8_BAR; PG8_SCHED;
            PG8_LDB(B1, 1, 1); PG8_STAGE(PG8_SB(1, 0), b3, voffB);
            PG8_BAR; PG8_WAIT_L(0); PG8_MMA(0, 1, At, B1); PG8_BAR;
            PG8_LDA(At, 1, 1); PG8_STAGE(PG8_SA(1, 0), a3, voffA);
            PG8_BAR; PG8_WAIT_L(0); PG8_MMA(1, 0, At, B0); PG8_BAR; PG8_SCHED;
            PG8_STAGE(PG8_SB(1, 1), b3 + hstep, voffB);
            PG8_WAIT_V(6); PG8_BAR; PG8_MMA(1, 1, At, B1); PG8_BAR;
            }
        }
        if constexpr (ALIGN_EPI) { if (wr == 0) PG8_BAR; }
        if constexpr (!Epi::AFTER_DRAIN) { E(acc, cur, wr, wc, fr, fq); S.done(cur); }
        if (!has_next) break;
#pragma unroll
        for (int a = 0; a < 2; ++a)
#pragma unroll
            for (int b = 0; b < 2; ++b)
#pragma unroll
                for (int m = 0; m < 4; ++m)
#pragma unroll
                    for (int n = 0; n < 2; ++n) acc[a][b][m][n] = (f32x4){0.f, 0.f, 0.f, 0.f};
        cur = nxt; cA = nA; cB = nB; ++ui;
        if constexpr (ALIGN_EPI) { if (wr == 1) PG8_BAR; }
    }
    PG8_WAIT_V(0);
    if constexpr (!ALIGN_EPI) { if (wr == 0) PG8_BAR; }
    PG8_BAR;
    if constexpr (Epi::AFTER_DRAIN) { E.fused(acc, cur, wr, wc, fr, fq, lds, wid, lane); S.done(cur); }
#undef PG8_SA
#undef PG8_SB
#undef PG8_STAGE
#undef PG8_LDA
#undef PG8_LDB
#undef PG8_MMA
#undef PG8_WAIT_V
#undef PG8_WAIT_L
#undef PG8_BAR
#undef PG8_SCHED
}
}
constexpr int SEQ = 2048, NB = 8, DM = 1024, M = NB * SEQ, FF = 2816, NUP = 2 * FF, NQKV = 3 * DM;
constexpr float QSCALE = 0.125f * 1.4426950408889634f;
constexpr float LAMBDA_INIT = 0.35550906f;
constexpr size_t MiB = 1u << 20;
constexpr size_t WS_SSQ = 256 * 1024;
constexpr size_t WS_ROPE = 1 * MiB;
constexpr size_t WS_WIN = 2 * MiB;
constexpr size_t WS_WOUT = 46 * MiB;
constexpr size_t WS_WQKV = 68 * MiB;
constexpr size_t WS_WO = 80 * MiB;
constexpr size_t WS_XA = 84 * MiB;
constexpr size_t WS_H = 116 * MiB;
constexpr size_t WS_Q = 116 * MiB, WS_K = 148 * MiB, WS_V = 180 * MiB;
constexpr size_t WS_O = 212 * MiB;
constexpr size_t WS_T = 244 * MiB;
constexpr size_t WS_END = 308 * MiB;
constexpr int LDS_BYTES = 147456;
constexpr int NPHASE = 16;

#define GAS __attribute__((address_space(1)))
#define LAS __attribute__((address_space(3)))
typedef unsigned short bf16;
typedef unsigned v4u __attribute__((ext_vector_type(4)));
typedef float f32x4 __attribute__((ext_vector_type(4)));
__device__ __forceinline__ unsigned f2bf(float f) { unsigned u = __builtin_bit_cast(unsigned, f); return (u + 0x7fffu + ((u >> 16) & 1u)) >> 16; }
__device__ __forceinline__ unsigned pk2(float lo, float hi) { return f2bf(lo) | (f2bf(hi) << 16); }
__device__ __forceinline__ float bflo(unsigned u) { return __uint_as_float(u << 16); }
__device__ __forceinline__ float bfhi(unsigned u) { return __uint_as_float(u & 0xffff0000u); }
__device__ __forceinline__ int tid_opaque() { int t = threadIdx.x; asm volatile("" : "+v"(t)); return t; }
__device__ __forceinline__ int bid_opaque() { int t = blockIdx.x; asm volatile("" : "+s"(t)); return t; }
__device__ __forceinline__ float wave_sum(float v) {
#pragma unroll
    for (int o = 1; o < 64; o <<= 1) v += __shfl_xor(v, o);
    return v;
}

struct Args { const float* x; const float* ng; const float* fg; const float* w_in; const float* w_out; const float* sb_qkv; const float* sb_o;
              const float* df_qkv; const float* df_o; const float* df_lam; const float* df_sub; float* out; unsigned char* ws; int ph_lo, ph_hi; };

__device__ __forceinline__ int dst_row(int mode, int n) {
    if (mode == 1) { const int isu = n >= FF ? 1 : 0, j = n - isu * FF; return 256 * (j >> 7) + 128 * isu + (j & 127); }
    if (mode == 2) { if (n < 2048) { const int d = n & 63; return (n & ~63) + (d < 32 ? 2 * d : 2 * (d - 32) + 1); } return n; }
    return n;
}
__device__ __forceinline__ void transpose_item(const float* W, int K, int N, bf16* WT, int mode, LAS float* scr, int item, int lane) {
    const int nblk = N / 32, kb = item / nblk, nb = item % nblk, k0 = 64 * kb, n0 = 32 * nb;
#pragma unroll 8
    for (int i = 0; i < 32; ++i) { const int kk = 2 * i + (lane >> 5); scr[kk * 33 + (lane & 31)] = W[(size_t)(k0 + kk) * N + n0 + (lane & 31)]; }
    asm volatile("s_waitcnt lgkmcnt(0)" ::: "memory");
    const int c = lane & 7;
#pragma unroll
    for (int j = 0; j < 4; ++j) { const int n = (lane >> 3) + 8 * j; const LAS float* s = scr + (8 * c) * 33 + n;
        v4u o; o.x = pk2(s[0 * 33], s[1 * 33]); o.y = pk2(s[2 * 33], s[3 * 33]); o.z = pk2(s[4 * 33], s[5 * 33]); o.w = pk2(s[6 * 33], s[7 * 33]);
        *(v4u*)(WT + (size_t)dst_row(mode, n0 + n) * K + k0 + 8 * c) = o; }
    asm volatile("s_waitcnt lgkmcnt(0)" ::: "memory");
}
__device__ __forceinline__ void prologue(const Args& a, LAS unsigned char* lds) {
    const int tid = tid_opaque(), lane = tid & 63, wave = tid >> 6; const int bid = bid_opaque();
    LAS float* scr = (LAS float*)(lds + wave * 16384);
    const int gw = bid * 8 + wave, NGW = gridDim.x * 8;
    unsigned char* ws = a.ws;
    for (int mi = 0; mi < 12; ++mi) {
        const float* W; bf16* WT; int K, N, mode;
        if (mi < 4) { W = a.w_in + (size_t)mi * DM * NUP; WT = (bf16*)(ws + WS_WIN) + (size_t)mi * NUP * DM; K = DM; N = NUP; mode = 1; }
        else if (mi < 8) { W = a.w_out + (size_t)(mi - 4) * FF * DM; WT = (bf16*)(ws + WS_WOUT) + (size_t)(mi - 4) * DM * FF; K = FF; N = DM; mode = 0; }
        else if (mi == 8) { W = a.sb_qkv; WT = (bf16*)(ws + WS_WQKV); K = DM; N = NQKV; mode = 0; }
        else if (mi == 9) { W = a.df_qkv; WT = (bf16*)(ws + WS_WQKV) + (size_t)NQKV * DM; K = DM; N = NQKV; mode = 2; }
        else if (mi == 10) { W = a.sb_o; WT = (bf16*)(ws + WS_WO); K = DM; N = DM; mode = 0; }
        else { W = a.df_o; WT = (bf16*)(ws + WS_WO) + (size_t)DM * DM; K = DM; N = DM; mode = 0; }
        const int nit = (K / 64) * (N / 32);
        for (int it = gw; it < nit; it += NGW) transpose_item(W, K, N, WT, mode, scr, it, lane);
    }
    float* ssq = (float*)(ws + WS_SSQ); bf16* XA = (bf16*)(ws + WS_XA);
    f32x4 gv[4];
#pragma unroll
    for (int j = 0; j < 4; ++j) gv[j] = *((const f32x4*)a.ng + lane + 64 * j);
    for (int m = gw; m < M; m += NGW) {
        const f32x4* xr = (const f32x4*)(a.x + (size_t)m * DM) + lane; f32x4 v[4]; float s = 0.f;
#pragma unroll
        for (int j = 0; j < 4; ++j) { v[j] = xr[64 * j]; s += (v[j][0] * v[j][0] + v[j][1] * v[j][1]) + (v[j][2] * v[j][2] + v[j][3] * v[j][3]); }
        s = wave_sum(s);
        if (lane == 0) ssq[m] = s;
        unsigned long long* o8 = (unsigned long long*)(XA + (size_t)m * DM) + lane;
#pragma unroll
        for (int j = 0; j < 4; ++j) { const f32x4 t = v[j] * gv[j]; o8[64 * j] = (unsigned long long)pk2(t[0], t[1]) | ((unsigned long long)pk2(t[2], t[3]) << 32); }
    }
    const int gt = bid * 512 + tid, NGT = gridDim.x * 512;
    for (int i = gt; i < 6 * M; i += NGT) ssq[M + i] = 0.f;
    float* rc = (float*)(ws + WS_ROPE); float* rsn = rc + 2048 * 32;
    for (int i = gt; i < 2048 * 32; i += NGT) { const int pos = i >> 5, fi = i & 31;
        const float inv = __builtin_amdgcn_exp2f(-(float)fi * (13.287712379549449f / 32.0f));
        const float ang = (float)pos * inv;
        const double rev = (double)ang * 0.15915494309189535; const float fr = (float)(rev - rint(rev));
        rc[i] = __builtin_amdgcn_cosf(fr); rsn[i] = __builtin_amdgcn_sinf(fr); }
}
__device__ __forceinline__ void final_norm(const Args& a) {
    const int tid = tid_opaque(), lane = tid & 63, wave = tid >> 6; const int bid = bid_opaque();
    const int gw = bid * 8 + wave, NGW = gridDim.x * 8;
    const float* ssq = (const float*)(a.ws + WS_SSQ) + 6 * M;
    f32x4 gv[4];
#pragma unroll
    for (int j = 0; j < 4; ++j) gv[j] = *((const f32x4*)a.fg + lane + 64 * j);
    for (int m = gw; m < M; m += NGW) { const float rs = pg8::rstd_of(ssq[m]); f32x4* xr = (f32x4*)(a.out + (size_t)m * DM) + lane;
#pragma unroll
        for (int j = 0; j < 4; ++j) xr[64 * j] = xr[64 * j] * rs * gv[j]; }
}

__device__ __forceinline__ void sb_attn_naive(const bf16* Q, const bf16* K, const bf16* V, bf16* O) {
    const int tidn = tid_opaque();
    for (int it = bid_opaque(); it < 512; it += gridDim.x) {
        const int bh = it & 127, qb = 3 - (it >> 7), b = bh >> 4, h = bh & 15;
        const int t = qb * 512 + tidn;
        const uint4* qp = (const uint4*)(Q + ((size_t)(b * SEQ + t)) * DM + h * 64);
        float q[64], o[64];
#pragma unroll
        for (int j = 0; j < 8; ++j) { const uint4 w = qp[j]; q[8 * j] = bflo(w.x); q[8 * j + 1] = bfhi(w.x); q[8 * j + 2] = bflo(w.y); q[8 * j + 3] = bfhi(w.y); q[8 * j + 4] = bflo(w.z); q[8 * j + 5] = bfhi(w.z); q[8 * j + 6] = bflo(w.w); q[8 * j + 7] = bfhi(w.w); }
#pragma unroll
        for (int d = 0; d < 64; ++d) o[d] = 0.f;
        float R = 0.f;
        for (int s = qb * 512 + 511; s >= 0; --s) {
            const uint4* kp = (const uint4*)(K + ((size_t)(b * SEQ + s)) * DM + h * 64);
            float z = 0.f;
#pragma unroll
            for (int j = 0; j < 8; ++j) { const uint4 w = kp[j]; z += q[8 * j] * bflo(w.x) + q[8 * j + 1] * bfhi(w.x) + q[8 * j + 2] * bflo(w.y) + q[8 * j + 3] * bfhi(w.y) + q[8 * j + 4] * bflo(w.z) + q[8 * j + 5] * bfhi(w.z) + q[8 * j + 6] * bflo(w.w) + q[8 * j + 7] * bfhi(w.w); }
            if (s < t) {
                const float sp = fmaxf(z, 0.f) + __builtin_amdgcn_logf(1.0f + __builtin_amdgcn_exp2f(-fabsf(z)));
                const float aw = __builtin_amdgcn_exp2f((z - sp) + R);
                R -= sp;
                const bf16* vp = V + ((size_t)(b * 1024 + h * 64)) * SEQ + s;
#pragma unroll
                for (int d = 0; d < 64; ++d) o[d] += aw * bflo((unsigned)vp[(size_t)d * SEQ]);
            }
        }
        uint4* op = (uint4*)(O + ((size_t)(b * SEQ + t)) * DM + h * 64);
#pragma unroll
        for (int j = 0; j < 8; ++j) { uint4 w; w.x = pk2(o[8 * j], o[8 * j + 1]); w.y = pk2(o[8 * j + 2], o[8 * j + 3]); w.z = pk2(o[8 * j + 4], o[8 * j + 5]); w.w = pk2(o[8 * j + 6], o[8 * j + 7]); op[j] = w; }
    }
}
__device__ __forceinline__ float diff_lambda(const float* lp) {
    float s1 = 0.f, s2 = 0.f;
    for (int i = 0; i < 64; ++i) { s1 += lp[i] * lp[64 + i]; s2 += lp[128 + i] * lp[192 + i]; }
    return expf(s1) - expf(s2) + LAMBDA_INIT;
}
__device__ __forceinline__ void diff_attn_naive(const bf16* Q, const bf16* K, const bf16* V, bf16* O, float* T, const float* lamp, const float* subg) {
    const float lam = diff_lambda(lamp);
    const int tidn = tid_opaque();
    for (int it = bid_opaque(); it < 256; it += gridDim.x) {
        const int bh = it & 63, qb = 3 - (it >> 6), b = bh >> 3, h = bh & 7;
        const int t = qb * 512 + tidn, kend = ((t >> 6) + 1) << 6;
        float* Tr = T + ((size_t)(b * SEQ + t)) * DM + h * 128;
        for (int vh = 0; vh < 2; ++vh)
            for (int mp = 0; mp < 2; ++mp) {
                const uint4* qp = (const uint4*)(Q + ((size_t)(b * SEQ + t)) * DM + (h * 2 + mp) * 64);
                float q[64], o[64];
#pragma unroll
                for (int j = 0; j < 8; ++j) { const uint4 w = qp[j]; q[8 * j] = bflo(w.x); q[8 * j + 1] = bfhi(w.x); q[8 * j + 2] = bflo(w.y); q[8 * j + 3] = bfhi(w.y); q[8 * j + 4] = bflo(w.z); q[8 * j + 5] = bfhi(w.z); q[8 * j + 6] = bflo(w.w); q[8 * j + 7] = bfhi(w.w); }
#pragma unroll
                for (int d = 0; d < 64; ++d) o[d] = 0.f;
                float mx = -1e30f, l = 0.f;
                for (int s = 0; s < qb * 512 + 512; ++s) {
                    const uint4* kp = (const uint4*)(K + ((size_t)(b * SEQ + s)) * DM + (h * 2 + mp) * 64);
                    float z = 0.f;
#pragma unroll
                    for (int j = 0; j < 8; ++j) { const uint4 w = kp[j]; z += q[8 * j] * bflo(w.x) + q[8 * j + 1] * bfhi(w.x) + q[8 * j + 2] * bflo(w.y) + q[8 * j + 3] * bfhi(w.y) + q[8 * j + 4] * bflo(w.z) + q[8 * j + 5] * bfhi(w.z) + q[8 * j + 6] * bflo(w.w) + q[8 * j + 7] * bfhi(w.w); }
                    if (s < kend) {
                        const float mn = fmaxf(mx, z), f = __builtin_amdgcn_exp2f(mx - mn), p = __builtin_amdgcn_exp2f(z - mn);
                        mx = mn; l = l * f + p;
                        const bf16* vp = V + ((size_t)(b * 1024 + h * 128 + vh * 64)) * SEQ + s;
#pragma unroll
                        for (int d = 0; d < 64; ++d) o[d] = o[d] * f + p * bflo((unsigned)vp[(size_t)d * SEQ]);
                    }
                }
                const float il = 1.0f / l;
                if (mp == 0) {
#pragma unroll
                    for (int d = 0; d < 64; d += 4) *(f32x4*)(Tr + vh * 64 + d) = (f32x4){o[d] * il, o[d + 1] * il, o[d + 2] * il, o[d + 3] * il};
                } else {
#pragma unroll
                    for (int d = 0; d < 64; d += 4) { const f32x4 p1 = *(const f32x4*)(Tr + vh * 64 + d);
                        *(f32x4*)(Tr + vh * 64 + d) = (f32x4){p1[0] - lam * o[d] * il, p1[1] - lam * o[d + 1] * il, p1[2] - lam * o[d + 2] * il, p1[3] - lam * o[d + 3] * il}; }
                }
            }
        float ss = 0.f;
        for (int d = 0; d < 128; d += 4) { const f32x4 v = *(const f32x4*)(Tr + d); ss += (v[0] * v[0] + v[1] * v[1]) + (v[2] * v[2] + v[3] * v[3]); }
        const float rs = (1.0f / sqrtf(ss * (1.0f / 128.0f) + 1e-6f)) * (1.0f - LAMBDA_INIT);
        bf16* Or = O + ((size_t)(b * SEQ + t)) * DM + h * 128;
        for (int d = 0; d < 128; d += 4) { const f32x4 v = *(const f32x4*)(Tr + d); const f32x4 g = *(const f32x4*)(subg + d);
            uint2 w; w.x = pk2(v[0] * rs * g[0], v[1] * rs * g[1]); w.y = pk2(v[2] * rs * g[2], v[3] * rs * g[3]); *(uint2*)(Or + d) = w; }
    }
}
typedef short a_bf16x8 __attribute__((ext_vector_type(8)));
typedef short a_s16x4 __attribute__((ext_vector_type(4)));
typedef _Float16 a_f16x8 __attribute__((ext_vector_type(8)));
typedef float a_f32x16 __attribute__((ext_vector_type(16)));
__device__ __forceinline__ int crow(int r, int hi) { return (r & 3) + 8 * (r >> 2) + 4 * hi; }
__device__ __forceinline__ unsigned a_cvtpk(float lo, float hi) { typedef float f2 __attribute__((ext_vector_type(2))); typedef __bf16 b2 __attribute__((ext_vector_type(2))); f2 v = {lo, hi}; b2 b = __builtin_convertvector(v, b2); return __builtin_bit_cast(unsigned, b); }
#define A_PACK_BF16(P0, P1, PW) do { \
    PW[0] = __builtin_bit_cast(a_bf16x8, (v4u){a_cvtpk(P0[0], P0[1]), a_cvtpk(P0[2], P0[3]), a_cvtpk(P0[4], P0[5]), a_cvtpk(P0[6], P0[7])}); \
    PW[1] = __builtin_bit_cast(a_bf16x8, (v4u){a_cvtpk(P0[8], P0[9]), a_cvtpk(P0[10], P0[11]), a_cvtpk(P0[12], P0[13]), a_cvtpk(P0[14], P0[15])}); \
    PW[2] = __builtin_bit_cast(a_bf16x8, (v4u){a_cvtpk(P1[0], P1[1]), a_cvtpk(P1[2], P1[3]), a_cvtpk(P1[4], P1[5]), a_cvtpk(P1[6], P1[7])}); \
    PW[3] = __builtin_bit_cast(a_bf16x8, (v4u){a_cvtpk(P1[8], P1[9]), a_cvtpk(P1[10], P1[11]), a_cvtpk(P1[12], P1[13]), a_cvtpk(P1[14], P1[15])}); } while (0)

__device__ __forceinline__ void sb_attn(const bf16* Q, const bf16* K, const bf16* VT, bf16* O, LAS unsigned char* lds) {
    const int tid = tid_opaque(), lane = tid & 63, r32 = lane & 31, hi = lane >> 5, wid = __builtin_amdgcn_readfirstlane(tid >> 6);
    const int c = bid_opaque(), G = gridDim.x;
    a_f16x8 TA0, TA1, ONES;
#pragma unroll
    for (int e = 0; e < 8; ++e) { const int kin = 4 * hi + (e & 3) + 8 * (e >> 2); TA0[e] = (kin > r32) ? (_Float16)1.0f : (_Float16)0.0f; TA1[e] = (16 + kin > r32) ? (_Float16)1.0f : (_Float16)0.0f; ONES[e] = (_Float16)1.0f; }
    for (int u = c; u < 1024; u += G) {
        const int cc = u & 255, ui = u >> 8, bh = cc >> 1, sg = cc & 1;
        const int qb = (ui == 0) ? 7 - sg : (ui == 1) ? sg : (ui == 2) ? 5 - sg : 2 + sg;
        const int b = bh >> 4, h = bh & 15;
        const int q0 = qb * 256 + wid * 32, td = q0 >> 6, Tmax = qb * 4 + 3, qloc = (q0 & 63) + r32;
        const bf16* Qw = Q + ((size_t)(b * SEQ + q0 + r32)) * DM + h * 64 + hi * 8;
        a_bf16x8 qr[4];
#pragma unroll
        for (int d0 = 0; d0 < 4; ++d0) qr[d0] = *(const a_bf16x8*)(Qw + d0 * 16);
        a_f32x16 ot[2]; ot[0] = (a_f32x16){}; ot[1] = (a_f32x16){};
        float R = 0.f;
        const bf16* kg = K + ((size_t)(b * SEQ + lane)) * DM + h * 64 + wid * 8;
        const bf16* vg = VT + ((size_t)(b * 1024 + h * 64 + lane)) * SEQ + wid * 8;
        v4u kreg = *(const v4u*)(kg + (size_t)Tmax * 64 * DM), vreg = *(const v4u*)(vg + Tmax * 64);
        for (int t = Tmax; t >= 0; --t) {
            LAS unsigned char* kb = lds + ((Tmax - t) & 1) * 16384; LAS unsigned char* vb = kb + 8192;
            *(LAS v4u*)(kb + wid * 1024 + lane * 16) = kreg; *(LAS v4u*)(vb + wid * 1024 + lane * 16) = vreg;
            if (t > 0) { kreg = *(const v4u*)(kg + (size_t)(t - 1) * 64 * DM); vreg = *(const v4u*)(vg + (t - 1) * 64); }
            __syncthreads();
            if (t <= td) {
                a_f32x16 p0 = (a_f32x16){}, p1 = (a_f32x16){};
#pragma unroll
                for (int d0 = 0; d0 < 4; ++d0) { const a_bf16x8 k0 = *(const LAS a_bf16x8*)(kb + (2 * d0 + hi) * 1024 + r32 * 16), k1 = *(const LAS a_bf16x8*)(kb + (2 * d0 + hi) * 1024 + 512 + r32 * 16);
                    p0 = __builtin_amdgcn_mfma_f32_32x32x16_bf16(k0, qr[d0], p0, 0, 0, 0); p1 = __builtin_amdgcn_mfma_f32_32x32x16_bf16(k1, qr[d0], p1, 0, 0, 0); }
                const bool diag = (t == td);
                float lv0[16], lv1[16];
#pragma unroll
                for (int r = 0; r < 16; ++r) {
                    { const float z = p0[r], uu = __builtin_amdgcn_logf(1.0f + __builtin_amdgcn_exp2f(-fabsf(z))); float sp = fmaxf(z, 0.f) + uu, ls = fminf(z, 0.f) - uu;
                      if (diag && crow(r, hi) >= qloc) { sp = 0.f; ls = -__builtin_inff(); } p0[r] = ls; lv0[r] = -sp; }
                    { const float z = p1[r], uu = __builtin_amdgcn_logf(1.0f + __builtin_amdgcn_exp2f(-fabsf(z))); float sp = fmaxf(z, 0.f) + uu, ls = fminf(z, 0.f) - uu;
                      if (diag && 32 + crow(r, hi) >= qloc) { sp = 0.f; ls = -__builtin_inff(); } p1[r] = ls; lv1[r] = -sp; }
                }
                a_f16x8 lw[4];
#pragma unroll
                for (int e = 0; e < 8; ++e) { lw[0][e] = (_Float16)lv0[e]; lw[1][e] = (_Float16)lv0[8 + e]; lw[2][e] = (_Float16)lv1[e]; lw[3][e] = (_Float16)lv1[8 + e]; }
                a_f32x16 s0, s1;
#pragma unroll
                for (int r = 0; r < 16; ++r) { s0[r] = R; s1[r] = R; }
                s0 = __builtin_amdgcn_mfma_f32_32x32x16_f16(TA0, lw[0], s0, 0, 0, 0); s0 = __builtin_amdgcn_mfma_f32_32x32x16_f16(TA1, lw[1], s0, 0, 0, 0);
                s0 = __builtin_amdgcn_mfma_f32_32x32x16_f16(ONES, lw[2], s0, 0, 0, 0); s0 = __builtin_amdgcn_mfma_f32_32x32x16_f16(ONES, lw[3], s0, 0, 0, 0);
                s1 = __builtin_amdgcn_mfma_f32_32x32x16_f16(TA0, lw[2], s1, 0, 0, 0); s1 = __builtin_amdgcn_mfma_f32_32x32x16_f16(TA1, lw[3], s1, 0, 0, 0);
                const float Rn = s0[0] + lv0[0];
                R = __shfl(Rn, r32);
#pragma unroll
                for (int r = 0; r < 16; ++r) { p0[r] = __builtin_amdgcn_exp2f(p0[r] + s0[r]); p1[r] = __builtin_amdgcn_exp2f(p1[r] + s1[r]); }
                a_bf16x8 pw[4]; A_PACK_BF16(p0, p1, pw);
#pragma unroll
                for (int blk = 0; blk < 2; ++blk)
#pragma unroll
                    for (int j = 0; j < 4; ++j) { const a_s16x4 lo = *(const LAS a_s16x4*)(vb + (2 * j) * 1024 + (32 * blk + r32) * 16 + 8 * hi), hh = *(const LAS a_s16x4*)(vb + (2 * j + 1) * 1024 + (32 * blk + r32) * 16 + 8 * hi);
                        const a_bf16x8 vf = (a_bf16x8){lo[0], lo[1], lo[2], lo[3], hh[0], hh[1], hh[2], hh[3]};
                        ot[blk] = __builtin_amdgcn_mfma_f32_32x32x16_bf16(vf, pw[j], ot[blk], 0, 0, 0); }
            }
        }
        bf16* Ow = O + ((size_t)(b * SEQ + q0 + r32)) * DM + h * 64 + 4 * hi;
#pragma unroll
        for (int blk = 0; blk < 2; ++blk)
#pragma unroll
            for (int g = 0; g < 4; ++g) { uint2 w; w.x = a_cvtpk(ot[blk][4 * g], ot[blk][4 * g + 1]); w.y = a_cvtpk(ot[blk][4 * g + 2], ot[blk][4 * g + 3]); *(uint2*)(Ow + 32 * blk + 8 * g) = w; }
    }
}

__device__ __forceinline__ void diff_attn(const bf16* Q, const bf16* K, const bf16* VT, bf16* O, const float* lamp, const float* subg, LAS unsigned char* lds) {
    const int tid = tid_opaque(), lane = tid & 63, r32 = lane & 31, hi = lane >> 5, wid = __builtin_amdgcn_readfirstlane(tid >> 6), mp = wid >> 2, w4 = wid & 3;
    const int c = bid_opaque(), G = gridDim.x;
    const float lam = diff_lambda(lamp);
    LAS float* ex = (LAS float*)(lds + 65536);
    for (int u = c; u < 1024; u += G) {
        const int cc = u & 255, ui = u >> 8, bh = cc >> 2, sg = cc & 3;
        const int qb = (ui == 0) ? 15 - sg : (ui == 1) ? 8 + sg : (ui == 2) ? 7 - sg : sg;
        const int b = bh >> 3, h = bh & 7;
        const int q0 = qb * 128 + w4 * 32, tdw = q0 >> 6, Tmax = qb * 2 + 1;
        const bf16* Qw = Q + ((size_t)(b * SEQ + q0 + r32)) * DM + (h * 2 + mp) * 64 + hi * 8;
        a_bf16x8 qr[4];
#pragma unroll
        for (int d0 = 0; d0 < 4; ++d0) qr[d0] = *(const a_bf16x8*)(Qw + d0 * 16);
        a_f32x16 ot[4];
#pragma unroll
        for (int i = 0; i < 4; ++i) ot[i] = (a_f32x16){};
        float mx = -1e30f, l = 0.f;
        const bf16* kg = K + ((size_t)(b * SEQ + lane)) * DM + h * 128 + wid * 8;
        const bf16* vg = VT + ((size_t)(b * 1024 + h * 128 + lane)) * SEQ + wid * 8;
        v4u k1r = *(const v4u*)(kg), k2r = *(const v4u*)(kg + 64), v1r = *(const v4u*)(vg), v2r = *(const v4u*)(vg + 64 * SEQ);
        for (int t = 0; t <= Tmax; ++t) {
            LAS unsigned char* base = lds + (t & 1) * 32768;
            *(LAS v4u*)(base + wid * 1024 + lane * 16) = k1r; *(LAS v4u*)(base + 8192 + wid * 1024 + lane * 16) = k2r;
            *(LAS v4u*)(base + 16384 + wid * 2048 + lane * 16) = v1r; *(LAS v4u*)(base + 16384 + wid * 2048 + (lane + 64) * 16) = v2r;
            if (t < Tmax) { const size_t ko = (size_t)(t + 1) * 64 * DM; const int vo = (t + 1) * 64;
                k1r = *(const v4u*)(kg + ko); k2r = *(const v4u*)(kg + ko + 64); v1r = *(const v4u*)(vg + vo); v2r = *(const v4u*)(vg + vo + 64 * SEQ); }
            __syncthreads();
            if (t <= tdw) {
                LAS unsigned char* kb = base + mp * 8192; LAS unsigned char* vb = base + 16384;
                a_f32x16 p0 = (a_f32x16){}, p1 = (a_f32x16){};
#pragma unroll
                for (int d0 = 0; d0 < 4; ++d0) { const a_bf16x8 k0 = *(const LAS a_bf16x8*)(kb + (2 * d0 + hi) * 1024 + r32 * 16), k1 = *(const LAS a_bf16x8*)(kb + (2 * d0 + hi) * 1024 + 512 + r32 * 16);
                    p0 = __builtin_amdgcn_mfma_f32_32x32x16_bf16(k0, qr[d0], p0, 0, 0, 0); p1 = __builtin_amdgcn_mfma_f32_32x32x16_bf16(k1, qr[d0], p1, 0, 0, 0); }
                float rm = fmaxf(p0[0], p1[0]);
#pragma unroll
                for (int r = 1; r < 16; ++r) rm = fmaxf(rm, fmaxf(p0[r], p1[r]));
                rm = fmaxf(rm, __shfl_xor(rm, 32));
                if (__any(rm > mx)) { const float mn = fmaxf(mx, rm), f = __builtin_amdgcn_exp2f(mx - mn); mx = mn; l *= f;
#pragma unroll
                    for (int i = 0; i < 4; ++i) ot[i] = ot[i] * f; }
                float ps = 0.f;
#pragma unroll
                for (int r = 0; r < 16; ++r) { p0[r] = __builtin_amdgcn_exp2f(p0[r] - mx); p1[r] = __builtin_amdgcn_exp2f(p1[r] - mx); ps += p0[r] + p1[r]; }
                l += ps;
                a_bf16x8 pw[4]; A_PACK_BF16(p0, p1, pw);
#pragma unroll
                for (int blk = 0; blk < 4; ++blk)
#pragma unroll
                    for (int j = 0; j < 4; ++j) { const a_s16x4 lo = *(const LAS a_s16x4*)(vb + (2 * j) * 2048 + (32 * blk + r32) * 16 + 8 * hi), hh = *(const LAS a_s16x4*)(vb + (2 * j + 1) * 2048 + (32 * blk + r32) * 16 + 8 * hi);
                        const a_bf16x8 vf = (a_bf16x8){lo[0], lo[1], lo[2], lo[3], hh[0], hh[1], hh[2], hh[3]};
                        ot[blk] = __builtin_amdgcn_mfma_f32_32x32x16_bf16(vf, pw[j], ot[blk], 0, 0, 0); }
            }
        }
        const float il = 1.0f / (l + __shfl_xor(l, 32));
        if (mp == 1) {
#pragma unroll
            for (int blk = 0; blk < 4; ++blk)
#pragma unroll
                for (int r = 0; r < 16; ++r) ex[((w4 * 4 + blk) * 16 + r) * 64 + lane] = ot[blk][r] * il;
        }
        __syncthreads();
        if (mp == 0) {
            float ss = 0.f;
#pragma unroll
            for (int blk = 0; blk < 4; ++blk)
#pragma unroll
                for (int r = 0; r < 16; ++r) { const float o = ot[blk][r] * il - lam * ex[((w4 * 4 + blk) * 16 + r) * 64 + lane]; ot[blk][r] = o; ss += o * o; }
            ss += __shfl_xor(ss, 32);
            const float rs = (1.0f / sqrtf(ss * (1.0f / 128.0f) + 1e-6f)) * (1.0f - LAMBDA_INIT);
            bf16* Ow = O + ((size_t)(b * SEQ + q0 + r32)) * DM + h * 128 + 4 * hi;
#pragma unroll
            for (int blk = 0; blk < 4; ++blk)
#pragma unroll
                for (int g = 0; g < 4; ++g) { const f32x4 gg = *(const f32x4*)(subg + 32 * blk + 8 * g + 4 * hi);
                    uint2 w; w.x = a_cvtpk(ot[blk][4 * g] * rs * gg[0], ot[blk][4 * g + 1] * rs * gg[1]); w.y = a_cvtpk(ot[blk][4 * g + 2] * rs * gg[2], ot[blk][4 * g + 3] * rs * gg[3]);
                    *(uint2*)(Ow + 32 * blk + 8 * g) = w; }
        }
    }
}
#define XB_TMO      128
#define XB_XCNT(j)  (256  + 64 * (j))
#define XB_XSUB(j)  (1280 + 64 * (j))
#define XB_XGEN(j)  (2304 + 64 * (j))
#define XB_TOP      3328
#define XB_TOPGEN   3392
#define XCD_BAR_WORDS 3456
#define XB_SPIN_CAP (1u << 18)

__device__ __forceinline__ unsigned xb_ld(unsigned* p)              { return __hip_atomic_load(p, __ATOMIC_RELAXED, __HIP_MEMORY_SCOPE_AGENT); }
__device__ __forceinline__ unsigned xb_add(unsigned* p, unsigned v) { return __hip_atomic_fetch_add(p, v, __ATOMIC_RELAXED, __HIP_MEMORY_SCOPE_AGENT); }
__device__ __forceinline__ unsigned xb_xcc_id() { return (unsigned)__builtin_amdgcn_s_getreg((3 << 11) | 20) & 0xFu; }
#define XB_SPIN(cond, bar) do { unsigned _sp = 0; while (cond) { __builtin_amdgcn_s_sleep(1); \
    if ((++_sp & 255u) == 0u) { if (xb_ld(&(bar)[XB_TMO])) break; if (_sp > XB_SPIN_CAP) { atomicAdd(&(bar)[XB_TMO], 1u); break; } } } } while (0)

struct XcdBarrier {
    unsigned* bar; unsigned x;
    volatile LAS unsigned* st;
};

__device__ __forceinline__ XcdBarrier xcd_barrier_post(unsigned* bar, volatile LAS unsigned* st) {
    XcdBarrier b; b.bar = bar; b.x = xb_xcc_id(); b.st = st;
    if (threadIdx.x == 0) (void)xb_add(&bar[XB_XCNT(b.x)], 1u);
    return b;
}
__device__ __forceinline__ void xcd_barrier_complete(unsigned* bar, unsigned x, unsigned& nloc, unsigned& nx) {
    const unsigned G = gridDim.x * gridDim.y * gridDim.z;
    unsigned sum, cnt, mine, sp = 0u;
    for (;;) {
        sum = 0u; cnt = 0u; mine = 0u;
#pragma unroll
        for (unsigned j = 0; j < 16; ++j) { const unsigned c = xb_ld(&bar[XB_XCNT(j)]); sum += c; cnt += (c > 0u) ? 1u : 0u; mine = (j == x) ? c : mine; }
        if (sum == G) break;
        __builtin_amdgcn_s_sleep(1);
        if ((++sp & 255u) == 0u) { if (xb_ld(&bar[XB_TMO])) break; if (sp > XB_SPIN_CAP) { atomicAdd(&bar[XB_TMO], 1u); break; } }
    }
    nloc = mine > 0u ? mine : 1u; nx = cnt > 0u ? cnt : 1u;
}

__device__ __forceinline__ void xcd_barrier(const XcdBarrier& b) {
    asm volatile("s_waitcnt vmcnt(0)" ::: "memory");
    __syncthreads();
    if (threadIdx.x == 0) {
        unsigned* bar = b.bar;
        __builtin_amdgcn_s_waitcnt(0);
        unsigned nloc = b.st[0], nx = b.st[1];
        if (nloc == 0u) { xcd_barrier_complete(bar, b.x, nloc, nx); b.st[0] = nloc; b.st[1] = nx; }
        const unsigned old = xb_add(&bar[XB_XSUB(b.x)], 1u);
        const unsigned gen = old / nloc;
        if (old + 1u == (gen + 1u) * nloc) {
            __builtin_amdgcn_fence(__ATOMIC_RELEASE, "agent");
            asm volatile("s_waitcnt vmcnt(0)" ::: "memory");
            const unsigned og = xb_add(&bar[XB_TOP], 1u);
            const unsigned tg = og / nx;
            if (og + 1u == (tg + 1u) * nx) xb_add(&bar[XB_TOPGEN], 1u);
            else XB_SPIN(xb_ld(&bar[XB_TOPGEN]) == tg, bar);
            __builtin_amdgcn_fence(__ATOMIC_ACQUIRE, "agent");
            xb_add(&bar[XB_XGEN(b.x)], 1u);
            asm volatile("s_waitcnt vmcnt(0)" ::: "memory");
        } else {
            XB_SPIN(xb_ld(&bar[XB_XGEN(b.x)]) == gen, bar);
            __builtin_amdgcn_fence(__ATOMIC_ACQUIRE, "agent");
            asm volatile("s_waitcnt vmcnt(0)" ::: "memory");
        }
    }
    __syncthreads();
}
#ifndef MK_MULTI
#define MK_MULTI 0
#endif
__global__ void __launch_bounds__(512, 2) mega(Args a_in) {
    extern __shared__ __attribute__((aligned(16))) unsigned char lds_raw[];
    LAS unsigned char* lds = (LAS unsigned char*)lds_raw;
    cg::grid_group grid = cg::this_grid();
    const int ph_lo = a_in.ph_lo, ph_hi = a_in.ph_hi;
    volatile LAS unsigned* MISC = (volatile LAS unsigned*)(lds + 131072 + 320);
    if (threadIdx.x < 32) MISC[threadIdx.x] = 0u;
    __syncthreads();
    XcdBarrier bar = xcd_barrier_post((unsigned*)a_in.ws, MISC + 8);
    for (int p = ph_lo; p < ph_hi; ++p) {
#if defined(MK_REREAD)

    unsigned long long apv = (unsigned long long)__builtin_amdgcn_kernarg_segment_ptr();
    unsigned aplo = (unsigned)apv, aphi = (unsigned)(apv >> 32); asm volatile("" : "+s"(aplo), "+s"(aphi));
    aplo = __builtin_amdgcn_readfirstlane(aplo); aphi = __builtin_amdgcn_readfirstlane(aphi);
    const __attribute__((address_space(4))) unsigned char* ap = (const __attribute__((address_space(4))) unsigned char*)(((unsigned long long)aphi << 32) | aplo);
    Args a; __builtin_memcpy(&a, ap, sizeof(Args));
#else
    const Args a = a_in;
#endif
    unsigned char* ws = a.ws;
    float* ssq = (float*)(ws + WS_SSQ);
    bf16* XA = (bf16*)(ws + WS_XA); bf16* H = (bf16*)(ws + WS_H); bf16* Q = (bf16*)(ws + WS_Q); bf16* Kb = (bf16*)(ws + WS_K); bf16* Vb = (bf16*)(ws + WS_V); bf16* O = (bf16*)(ws + WS_O);
    const bf16* Win = (const bf16*)(ws + WS_WIN); const bf16* Wout = (const bf16*)(ws + WS_WOUT); const bf16* Wqkv = (const bf16*)(ws + WS_WQKV); const bf16* Wo = (const bf16*)(ws + WS_WO);
    const int G = gridDim.x, c = bid_opaque();
    {
        if (p == 0) {
#ifndef NO_PRO
 prologue(a, lds);
#if defined(PROBE_PRO2)
 __syncthreads(); prologue(a, lds);
#endif
#endif
 }
        else if (p == NPHASE - 1) final_norm(a);
        else {
            const int L = (p - 1) / 7, s = (p - 1) % 7;
            if (s == 0 || s == 5) {
                const int ab = (s == 5) ? 1 : 0;
                pg8::Gemm g{XA, Win + (size_t)(L * 2 + ab) * NUP * DM, M, NUP, DM}; pg8::StaticOrder S; S.init(M, NUP, G, c);
                pg8::EpiSwiglu E{H, ssq + (size_t)(3 * L + 2 * ab) * M, FF};

#ifndef NO_UP
 pg8::gemm_phase<pg8::EpiSwiglu, pg8::StaticOrder, true, true>(lds, g, S, E);
#if defined(PROBE_UP2)
 __syncthreads(); pg8::gemm_phase<pg8::EpiSwiglu, pg8::StaticOrder, true, true>(lds, g, S, E);
#endif
#endif

            } else if (s == 1 || s == 4 || s == 6) {
                const bf16* A; const bf16* Bt; int K; float alpha; int nn; const float* gain;
                if (s == 4) { A = O; Bt = Wo + (size_t)L * DM * DM; K = DM; alpha = 1.0f; nn = 3 * L + 2; gain = a.ng + (size_t)(3 * L + 2) * DM; }
                else if (s == 1) { A = H; Bt = Wout + (size_t)(L * 2) * DM * FF; K = FF; alpha = 0.5f; nn = 3 * L + 1; gain = a.ng + (size_t)(3 * L + 1) * DM; }
                else { A = H; Bt = Wout + (size_t)(L * 2 + 1) * DM * FF; K = FF; alpha = 0.5f; nn = 3 * L + 3; gain = (L == 1) ? a.fg : a.ng + (size_t)(3 * L + 3) * DM; }
                pg8::Gemm g{A, Bt, M, DM, K}; pg8::StaticOrder S; S.init(M, DM, G, c);
                pg8::EpiRes E{(p == 2) ? a.x : a.out, a.out, XA, gain, ssq + (size_t)nn * M, alpha};

#ifndef NO_RES
 pg8::gemm_phase<pg8::EpiRes, pg8::StaticOrder, true, true>(lds, g, S, E);
#endif

            } else if (s == 2) {
                pg8::Gemm g{XA, Wqkv + (size_t)L * NQKV * DM, M, NQKV, DM}; pg8::StaticOrder S; S.init(M, NQKV, G, c);
                const float* rc = (const float*)(ws + WS_ROPE);
                pg8::EpiQKV E{Q, (size_t)(WS_K - WS_Q) / 2, ssq + (size_t)(3 * L + 1) * M, QSCALE, L == 1 ? rc : nullptr, rc + 2048 * 32};

#ifndef NO_QKV
 pg8::gemm_phase<pg8::EpiQKV, pg8::StaticOrder, true, true>(lds, g, S, E);
#if defined(PROBE_QKV2)
 __syncthreads(); pg8::gemm_phase<pg8::EpiQKV, pg8::StaticOrder, true, true>(lds, g, S, E);
#endif
#endif

            } else {

#if defined(SB_NAIVE)
                if (L == 0) sb_attn_naive(Q, Kb, Vb, O);
#else
                if (L == 0) { sb_attn(Q, Kb, Vb, O, lds);
#if defined(PROBE_SB2)
 __syncthreads(); sb_attn(Q, Kb, Vb, O, lds);
#endif
 }
#endif
#if defined(DF_NAIVE)
                if (L == 1) diff_attn_naive(Q, Kb, Vb, O, (float*)(ws + WS_T), a.df_lam, a.df_sub);
#else
                if (L == 1) { diff_attn(Q, Kb, Vb, O, a.df_lam, a.df_sub, lds);
#if defined(PROBE_DF2)
 __syncthreads(); diff_attn(Q, Kb, Vb, O, a.df_lam, a.df_sub, lds);
#endif
 }
#endif

            }
        }
        if (p + 1 < ph_hi) {
#if defined(MK_ALL_CG)
            grid.sync();
#else
            if (p == 0) grid.sync(); else xcd_barrier(bar);
#endif
        }
    }
    }
}

extern "C" void kernel_launch(void* const* d_in, const int* in_sizes, int n_in, void* d_out, int out_size, void* d_ws, size_t ws_size, hipStream_t stream) {
    static int grid = 0;
    if (grid == 0) {
        if (n_in != 11 || in_sizes[0] != M * DM || out_size != M * DM || ws_size < WS_END) { fprintf(stderr, "kernel_launch: unexpected shapes (n_in %d, in0 %d, out %d, ws %zu)\n", n_in, n_in > 0 ? in_sizes[0] : -1, out_size, ws_size); grid = -1; return; }
        int dev = 0, cus = 0, per_cu = 0;
        if (hipGetDevice(&dev) != hipSuccess || hipDeviceGetAttribute(&cus, hipDeviceAttributeMultiprocessorCount, dev) != hipSuccess) { grid = -1; return; }
        if (hipFuncSetAttribute((const void*)mega, hipFuncAttributeMaxDynamicSharedMemorySize, LDS_BYTES) != hipSuccess) { fprintf(stderr, "kernel_launch: hipFuncSetAttribute failed\n"); grid = -1; return; }
        if (hipOccupancyMaxActiveBlocksPerMultiprocessor(&per_cu, (const void*)mega, 512, LDS_BYTES) != hipSuccess || per_cu < 1) { fprintf(stderr, "kernel_launch: occupancy query gave %d\n", per_cu); per_cu = 1; }
        (void)hipGetLastError();
        grid = cus * (per_cu > 1 ? 1 : per_cu);
    }
    if (grid < 0) return;
    if (hipMemsetAsync(d_ws, 0, 16384, stream) != hipSuccess) { fprintf(stderr, "kernel_launch: memset failed\n"); return; }
    Args a{};
    a.x = (const float*)d_in[0]; a.ng = (const float*)d_in[1]; a.fg = (const float*)d_in[2]; a.w_in = (const float*)d_in[3]; a.w_out = (const float*)d_in[4];
    a.sb_qkv = (const float*)d_in[5]; a.sb_o = (const float*)d_in[6]; a.df_qkv = (const float*)d_in[7]; a.df_o = (const float*)d_in[8]; a.df_lam = (const float*)d_in[9]; a.df_sub = (const float*)d_in[10];
    a.out = (float*)d_out; a.ws = (unsigned char*)d_ws;
#if MK_MULTI
    for (int p = 0; p < NPHASE; ++p) { a.ph_lo = p; a.ph_hi = p + 1; hipLaunchKernelGGL(mega, dim3(grid), dim3(512), LDS_BYTES, stream, a); }
#else
    a.ph_lo = 0; a.ph_hi = NPHASE;
    void* args[] = {&a};
    hipError_t e = hipLaunchCooperativeKernel((const void*)mega, dim3(grid), dim3(512), args, LDS_BYTES, stream);
    if (e != hipSuccess) fprintf(stderr, "cooperative launch failed: %s (grid %d)\n", hipGetErrorString(e), grid);
#endif
}
```

```cpp
#include <hip/hip_runtime.h>
#include <hip/hip_cooperative_groups.h>
#include <cstdio>
#include <cstdint>
namespace cg = cooperative_groups;
namespace pg8 {
#define PG8_LAS __attribute__((address_space(3)))
typedef unsigned short bf16_t;
typedef short bf16x8 __attribute__((ext_vector_type(8)));
typedef float f32x4 __attribute__((ext_vector_type(4)));
typedef unsigned u32x4 __attribute__((ext_vector_type(4)));
constexpr int BM = 256, BK = 64, HALF = 128, HTB = HALF * BK * 2  , STAGE_BYTES = 8 * HTB, NXCD = 8, WGM = 8;

__host__ __device__ __forceinline__ int lds_byte(int r, int c) { const int st = (r >> 4) * 2 + (c >> 5), rr = r & 15, cc = c & 31, ob = rr * 64 + cc * 2; return st * 1024 + (ob ^ (((ob >> 9) & 1) << 5)); }
__host__ __device__ __forceinline__ void stage_rc(int b, int& R, int& C) { const int st = b / 1024, sb = b % 1024, swz = sb ^ (((sb >> 9) & 1) << 5); R = (st >> 1) * 16 + swz / 64; C = (st & 1) * 32 + (swz % 64) / 2; }
__host__ __device__ __forceinline__ int perm32(int rho) { const int n = rho >> 4, i = rho & 15; return 8 * (i >> 2) + 4 * n + (i & 3); }

struct Unit { int pm, pn; };
struct Gemm { const bf16_t* A; const bf16_t* Bt; int M, N, K; };

struct StaticOrder {
    int nM, nN, nwg, G, c;
    __host__ __device__ void init(int M, int N, int G_, int c_) { nM = M / BM; nN = N / BM; nwg = nM * nN; G = G_; c = c_; }
    __host__ __device__ bool next(int i, Unit& u) const {
        const long L = (long)i * G + c; if (L >= nwg) return false;
        int wgid = (int)L; { const int q = nwg / NXCD, r = nwg % NXCD, xcd = wgid % NXCD, off = wgid / NXCD; wgid = (xcd < r ? xcd * (q + 1) : r * (q + 1) + (xcd - r) * q) + off; }
        const int nig = WGM * nN, gid = wgid / nig, fm = gid * WGM, gsz = (nM - fm) < WGM ? (nM - fm) : WGM;
        u.pm = fm + ((wgid % nig) % gsz); u.pn = (wgid % nig) / gsz; return true;
    }
    __device__ __forceinline__ void a_ready(const Unit&) const {}
    __device__ __forceinline__ void done(const Unit&) const {}
};
__device__ __forceinline__ unsigned cvt_pk_bf16(float lo, float hi) { unsigned r; asm volatile("v_cvt_pk_bf16_f32 %0, %1, %2" : "=v"(r) : "v"(lo), "v"(hi)); return r; }
typedef float f32x2 __attribute__((ext_vector_type(2)));
__device__ __forceinline__ float rstd_of(float ssq) { return 1.0f / sqrtf(ssq * (1.0f / 1024.0f) + 1e-6f); }
struct EpiSwiglu {
    static constexpr bool PERM = true, AFTER_DRAIN = false;
    bf16_t* H; const float* ssq; int ldh;
    __device__ __forceinline__ void operator()(const f32x4 (&acc)[2][2][4][2], const Unit& u, int wr, int wc, int fr, int fq) const {
        const int row0 = u.pm * BM + wr * 64 + fr, hcol = u.pn * HALF + wc * 32 + 8 * fq;
#pragma unroll
        for (int ai = 0; ai < 2; ++ai)
#pragma unroll
            for (int m = 0; m < 4; ++m) { const int row = row0 + ai * HALF + m * 16; const float rs = rstd_of(ssq[row]);
                float hv[8];
#pragma unroll
                for (int n = 0; n < 2; ++n)
#pragma unroll
                    for (int e = 0; e < 4; ++e) { const float g = acc[ai][0][m][n][e] * rs, up = acc[ai][1][m][n][e] * rs;
                        const float ex = __builtin_amdgcn_exp2f(-g * 1.4426950408889634f);
                        hv[n * 4 + e] = g * up * __builtin_amdgcn_rcpf(1.0f + ex); }
                u32x4 w; w.x = cvt_pk_bf16(hv[0], hv[1]); w.y = cvt_pk_bf16(hv[2], hv[3]); w.z = cvt_pk_bf16(hv[4], hv[5]); w.w = cvt_pk_bf16(hv[6], hv[7]);
                *(u32x4*)(H + (size_t)row * ldh + hcol) = w; }
    }
};
struct EpiRes {
    static constexpr bool PERM = true, AFTER_DRAIN = false;
    const float* base; float* out; bf16_t* xa; const float* gain; float* ssq; float alpha;
    __device__ __forceinline__ void operator()(const f32x4 (&acc)[2][2][4][2], const Unit& u, int wr, int wc, int fr, int fq) const {
        const int row0 = u.pm * BM + wr * 64 + fr, col0 = u.pn * BM + wc * 32 + 8 * fq;
        f32x4 gv[2][2];
#pragma unroll
        for (int bj = 0; bj < 2; ++bj)
#pragma unroll
            for (int n = 0; n < 2; ++n) gv[bj][n] = *(const f32x4*)(gain + col0 + bj * HALF + 4 * n);
#pragma unroll
        for (int ai = 0; ai < 2; ++ai)
#pragma unroll
            for (int m = 0; m < 4; ++m) { const int row = row0 + ai * HALF + m * 16; float s = 0.f;
#pragma unroll
                for (int bj = 0; bj < 2; ++bj) { const size_t off = (size_t)row * 1024 + col0 + bj * HALF;
                    const f32x4 b0 = *(const f32x4*)(base + off), b1 = *(const f32x4*)(base + off + 4);
                    const f32x4 v0 = b0 + acc[ai][bj][m][0] * alpha, v1 = b1 + acc[ai][bj][m][1] * alpha;
                    *(f32x4*)(out + off) = v0; *(f32x4*)(out + off + 4) = v1;
                    s += (v0[0] * v0[0] + v0[1] * v0[1]) + (v0[2] * v0[2] + v0[3] * v0[3]) + (v1[0] * v1[0] + v1[1] * v1[1]) + (v1[2] * v1[2] + v1[3] * v1[3]);
                    const f32x4 a0 = v0 * gv[bj][0], a1 = v1 * gv[bj][1];
                    u32x4 w; w.x = cvt_pk_bf16(a0[0], a0[1]); w.y = cvt_pk_bf16(a0[2], a0[3]); w.z = cvt_pk_bf16(a1[0], a1[1]); w.w = cvt_pk_bf16(a1[2], a1[3]);
                    *(u32x4*)(xa + off) = w; }
                s += __shfl_xor(s, 16); s += __shfl_xor(s, 32);
                if (fq == 0) __hip_atomic_fetch_add(ssq + row, s, __ATOMIC_RELAXED, __HIP_MEMORY_SCOPE_AGENT); }
    }
};
struct EpiQKV {
    static constexpr bool PERM = true, AFTER_DRAIN = false;
    bf16_t* O; size_t stride; const float* ssq; float qscale; const float* rcos; const float* rsin;
    __device__ __forceinline__ void operator()(const f32x4 (&acc)[2][2][4][2], const Unit& u, int wr, int wc, int fr, int fq) const {
        const int t = u.pn >> 2, colt = (u.pn & 3) * BM;
        bf16_t* basep = O + (size_t)t * stride;
        const int row0 = u.pm * BM + wr * 64 + fr, col0 = colt + wc * 32 + 8 * fq;
        const float sc0 = (t == 0) ? qscale : 1.0f;
        const bool dorope = (rcos != nullptr) && (t < 2);
        const int pr0 = (wc & 1) * 16 + 4 * fq;
        if (t == 2) {
#pragma unroll
            for (int ai = 0; ai < 2; ++ai)
#pragma unroll
                for (int m = 0; m < 4; ++m) { const int row = row0 + ai * HALF + m * 16; const float sc = rstd_of(ssq[row]);
                    bf16_t* vp = basep + ((size_t)((row >> 11) * 1024 + col0)) * 2048 + (row & 2047);
#pragma unroll
                    for (int bj = 0; bj < 2; ++bj)
#pragma unroll
                        for (int n = 0; n < 2; ++n)
#pragma unroll
                            for (int e = 0; e < 4; ++e) { const unsigned w = cvt_pk_bf16(acc[ai][bj][m][n][e] * sc, 0.f); vp[(size_t)(bj * HALF + n * 4 + e) * 2048] = (bf16_t)w; } }
            return;
        }
#pragma unroll
        for (int ai = 0; ai < 2; ++ai)
#pragma unroll
            for (int m = 0; m < 4; ++m) { const int row = row0 + ai * HALF + m * 16; const float sc = rstd_of(ssq[row]) * sc0;
                f32x4 cs = (f32x4){1.f, 1.f, 1.f, 1.f}, sn = (f32x4){0.f, 0.f, 0.f, 0.f};
                if (dorope) { const int pos = row & 2047; cs = *(const f32x4*)(rcos + pos * 32 + pr0); sn = *(const f32x4*)(rsin + pos * 32 + pr0); }
#pragma unroll
                for (int bj = 0; bj < 2; ++bj) { const f32x4 v0 = acc[ai][bj][m][0] * sc, v1 = acc[ai][bj][m][1] * sc;
                    float o[8];
                    o[0] = v0[0] * cs[0] - v0[1] * sn[0]; o[1] = v0[1] * cs[0] + v0[0] * sn[0];
                    o[2] = v0[2] * cs[1] - v0[3] * sn[1]; o[3] = v0[3] * cs[1] + v0[2] * sn[1];
                    o[4] = v1[0] * cs[2] - v1[1] * sn[2]; o[5] = v1[1] * cs[2] + v1[0] * sn[2];
                    o[6] = v1[2] * cs[3] - v1[3] * sn[3]; o[7] = v1[3] * cs[3] + v1[2] * sn[3];
                    u32x4 w; w.x = cvt_pk_bf16(o[0], o[1]); w.y = cvt_pk_bf16(o[2], o[3]); w.z = cvt_pk_bf16(o[4], o[5]); w.w = cvt_pk_bf16(o[6], o[7]);
                    *(u32x4*)(basep + (size_t)row * 1024 + col0 + bj * HALF) = w; } }
    }
};
template <class Epi, class Sched, bool ALIGN_EPI = false, bool SP2 = false>
__device__ __forceinline__ void gemm_phase(PG8_LAS unsigned char* lds, const Gemm g, const Sched& S, const Epi& E) {
    int tid_ = threadIdx.x; asm volatile("" : "+v"(tid_));
    const int tid = tid_, wid = __builtin_amdgcn_readfirstlane(tid >> 6), lane = tid & 63, wr = wid >> 2, wc = wid & 3, fr = lane & 15, fq = lane >> 4;
    const int K = g.K, nt = K / BK;
    unsigned voffA[2], voffB[2];
#pragma unroll
    for (int i = 0; i < 2; ++i) { int R, C; stage_rc(tid * 16 + i * 8192, R, C); const int Rb = Epi::PERM ? ((R & ~31) + perm32(R & 31)) : R;
        voffA[i] = (unsigned)(R * K + C) * 2u; voffB[i] = (unsigned)(Rb * K + C) * 2u; }
    const size_t kstep = (size_t)(BK * 2);
    const size_t hstep = (size_t)HALF * K * 2;
    const size_t tstep = 2 * hstep;
    const unsigned ldsw = (unsigned)wid * 1024u;
    const int aoff = lds_byte(wr * 64 + fr, fq * 8), boff = lds_byte(wc * 32 + fr, fq * 8);
#define PG8_SA(b, h) (((b) * 2 + (h)) * HTB)
#define PG8_SB(b, h) ((4 + (b) * 2 + (h)) * HTB)
#define PG8_STAGE(bufoff, gbase, voff) do { _Pragma("unroll") for (int _i = 0; _i < 2; ++_i) \
        __builtin_amdgcn_global_load_lds((const unsigned*)((const char*)(gbase) + (voff)[_i]), (PG8_LAS unsigned*)(lds + (bufoff) + ldsw + _i * 8192), 16, 0, 0); } while (0)
#define PG8_LDA(dst, b, h) do { _Pragma("unroll") for (int m = 0; m < 4; ++m) _Pragma("unroll") for (int k = 0; k < 2; ++k) dst[m][k] = *(const PG8_LAS bf16x8*)(lds + PG8_SA(b, h) + aoff + m * 2048 + k * 1024); } while (0)
#define PG8_LDB(dst, b, h) do { _Pragma("unroll") for (int n = 0; n < 2; ++n) _Pragma("unroll") for (int k = 0; k < 2; ++k) dst[n][k] = *(const PG8_LAS bf16x8*)(lds + PG8_SB(b, h) + boff + n * 2048 + k * 1024); } while (0)
#define PG8_MMA(ai, bj, At, Bt) do { __builtin_amdgcn_s_setprio(1); _Pragma("unroll") for (int m = 0; m < 4; ++m) _Pragma("unroll") for (int n = 0; n < 2; ++n) _Pragma("unroll") for (int k = 0; k < 2; ++k) \
        acc[ai][bj][m][n] = __builtin_amdgcn_mfma_f32_16x16x32_bf16(Bt[n][k], At[m][k], acc[ai][bj][m][n], 0, 0, 0); __builtin_amdgcn_s_setprio(0); } while (0)
#define PG8_WAIT_V(n) asm volatile("s_waitcnt vmcnt(" #n ")" ::: "memory")
#define PG8_WAIT_L(n) asm volatile("s_waitcnt lgkmcnt(" #n ")" ::: "memory")
#define PG8_BAR __builtin_amdgcn_s_barrier()
#define PG8_SCHED __builtin_amdgcn_sched_barrier(0)
    Unit cur, nxt; int ui = 0;
    if (!S.next(0, cur)) return;
    f32x4 acc[2][2][4][2];
#pragma unroll
    for (int a = 0; a < 2; ++a)
#pragma unroll
        for (int b = 0; b < 2; ++b)
#pragma unroll
            for (int m = 0; m < 4; ++m)
#pragma unroll
                for (int n = 0; n < 2; ++n) acc[a][b][m][n] = (f32x4){0.f, 0.f, 0.f, 0.f};
    bf16x8 At[4][2], B0[2][2], B1[2][2];
    const char* cA = (const char*)g.A + (size_t)cur.pm * tstep; const char* cB = (const char*)g.Bt + (size_t)cur.pn * tstep;
    S.a_ready(cur);
    if constexpr (SP2) {
        PG8_STAGE(PG8_SB(0, 0), cB, voffB); PG8_STAGE(PG8_SB(0, 1), cB + hstep, voffB); PG8_STAGE(PG8_SA(0, 0), cA, voffA); PG8_STAGE(PG8_SA(0, 1), cA + hstep, voffA);
        if (wr == 1) PG8_BAR;
        PG8_WAIT_V(2); PG8_BAR;
        PG8_STAGE(PG8_SB(1, 0), cB + kstep, voffB); PG8_STAGE(PG8_SA(1, 0), cA + kstep, voffA); PG8_STAGE(PG8_SB(1, 1), cB + hstep + kstep, voffB);
        PG8_WAIT_V(6); PG8_BAR;
    } else {
        PG8_STAGE(PG8_SB(0, 0), cB, voffB); PG8_STAGE(PG8_SA(0, 0), cA, voffA); PG8_STAGE(PG8_SB(0, 1), cB + hstep, voffB); PG8_STAGE(PG8_SA(0, 1), cA + hstep, voffA);
        if (wr == 1) PG8_BAR;
        PG8_WAIT_V(4); PG8_BAR;
        PG8_STAGE(PG8_SB(1, 0), cB + kstep, voffB); PG8_STAGE(PG8_SA(1, 0), cA + kstep, voffA); PG8_STAGE(PG8_SB(1, 1), cB + hstep + kstep, voffB);
        PG8_WAIT_V(6); PG8_BAR;
    }
    for (;;) {
        const bool has_next = S.next(ui + 1, nxt);
        const char* nA = has_next ? (const char*)g.A + (size_t)nxt.pm * tstep : cA; const char* nB = has_next ? (const char*)g.Bt + (size_t)nxt.pn * tstep : cB;
        for (int t = 0; t < nt; t += 2) {
            const bool last = (t == nt - 2);
            const char* a1 = cA + (size_t)(t + 1) * kstep;
            const char* a2 = last ? nA : cA + (size_t)(t + 2) * kstep; const char* b2 = last ? nB : cB + (size_t)(t + 2) * kstep;
            const char* a3 = a2 + kstep; const char* b3 = b2 + kstep;
            if (last && has_next) S.a_ready(nxt);
            if constexpr (SP2) {
            PG8_LDB(B0, 0, 0); PG8_LDB(B1, 0, 1); PG8_SCHED; PG8_LDA(At, 0, 0); PG8_STAGE(PG8_SA(1, 1), a1 + hstep, voffA);
            PG8_WAIT_V(8); PG8_WAIT_L(0); PG8_BAR; PG8_MMA(0, 0, At, B0); PG8_MMA(0, 1, At, B1); PG8_BAR; PG8_SCHED;
            PG8_LDA(At, 0, 1); PG8_STAGE(PG8_SB(0, 0), b2, voffB); PG8_STAGE(PG8_SB(0, 1), b2 + hstep, voffB); PG8_STAGE(PG8_SA(0, 0), a2, voffA);
            PG8_WAIT_V(8); PG8_WAIT_L(0); PG8_BAR; PG8_MMA(1, 0, At, B0); PG8_MMA(1, 1, At, B1); PG8_BAR; PG8_SCHED;
            PG8_LDB(B0, 1, 0); PG8_LDB(B1, 1, 1); PG8_SCHED; PG8_LDA(At, 1, 0); PG8_STAGE(PG8_SA(0, 1), a2 + hstep, voffA);
            PG8_WAIT_V(8); PG8_WAIT_L(0); PG8_BAR; PG8_MMA(0, 0, At, B0); PG8_MMA(0, 1, At, B1); PG8_BAR; PG8_SCHED;
            PG8_LDA(At, 1, 1); PG8_STAGE(PG8_SB(1, 0), b3, voffB); PG8_STAGE(PG8_SB(1, 1), b3 + hstep, voffB); PG8_STAGE(PG8_SA(1, 0), a3, voffA);
            PG8_WAIT_V(8); PG8_WAIT_L(0); PG8_BAR; PG8_MMA(1, 0, At, B0); PG8_MMA(1, 1, At, B1); PG8_BAR; PG8_SCHED;
            } else {
            PG8_LDB(B0, 0, 0); PG8_SCHED; PG8_LDA(At, 0, 0); PG8_STAGE(PG8_SA(1, 1), a1 + hstep, voffA);
            PG8_WAIT_L(8); PG8_BAR; PG8_WAIT_L(0); PG8_MMA(0, 0, At, B0); PG8_BAR; PG8_SCHED;
            PG8_LDB(B1, 0, 1); PG8_STAGE(PG8_SB(0, 0), b2, voffB);
            PG8_BAR; PG8_WAIT_L(0); PG8_MMA(0, 1, At, B1); PG8_BAR;
            PG8_LDA(At, 0, 1); PG8_STAGE(PG8_SA(0, 0), a2, voffA);
            PG8_BAR; PG8_WAIT_L(0); PG8_MMA(1, 0, At, B0); PG8_BAR; PG8_SCHED;
            PG8_STAGE(PG8_SB(0, 1), b2 + hstep, voffB);
            PG8_WAIT_V(6); PG8_BAR; PG8_MMA(1, 1, At, B1); PG8_BAR;
            PG8_LDB(B0, 1, 0); PG8_SCHED; PG8_LDA(At, 1, 0); PG8_STAGE(PG8_SA(0, 1), a2 + hstep, voffA);
            PG8_WAIT_L(8); PG8_BAR; PG8_WAIT_L(0); PG8_MMA(0, 0, At, B0); PG8_BAR; PG8_SCHED;
            PG8_LDB(B1, 1, 1); PG8_STAGE(PG8_SB(1, 0), b3, voffB);
            PG8_BAR; PG8_WAIT_L(0); PG8_MMA(0, 1, At, B1); PG8_BAR;
            PG8_LDA(At, 1, 1); PG8_STAGE(PG8_SA(1, 0), a3, voffA);
            PG8_BAR; PG8_WAIT_L(0); PG8_MMA(1, 0, At, B0); PG8_BAR; PG8_SCHED;
            PG8_STAGE(PG8_SB(1, 1), b3 + hstep, voffB);
            PG8_WAIT_V(6); PG8_BAR; PG8_MMA(1, 1, At, B1); PG8_BAR;
            }
        }
        if constexpr (ALIGN_EPI) { if (wr == 0) PG8_BAR; }
        if constexpr (!Epi::AFTER_DRAIN) { E(acc, cur, wr, wc, fr, fq); S.done(cur); }
        if (!has_next) break;
#pragma unroll
        for (int a = 0; a < 2; ++a)
#pragma unroll
            for (int b = 0; b < 2; ++b)
#pragma unroll
                for (int m = 0; m < 4; ++m)
#pragma unroll
                    for (int n = 0; n < 2; ++n) acc[a][b][m][n] = (f32x4){0.f, 0.f, 0.f, 0.f};
        cur = nxt; cA = nA; cB = nB; ++ui;
        if constexpr (ALIGN_EPI) { if (wr == 1) PG8_BAR; }
    }
    PG8_WAIT_V(0);
    if constexpr (!ALIGN_EPI) { if (wr == 0) PG8_BAR; }
    PG8_BAR;
    if constexpr (Epi::AFTER_DRAIN) { E.fused(acc, cur, wr, wc, fr, fq, lds, wid, lane); S.done(cur); }
#undef PG8_SA
#undef PG8_SB
#undef PG8_STAGE
#undef PG8_LDA
#undef PG8_LDB
#undef PG8_MMA
#undef PG8_WAIT_V
#undef PG8_WAIT_L
#undef PG8_BAR
#undef PG8_SCHED
}
}
constexpr int SEQ = 2048, NB = 8, DM = 1024, M = NB * SEQ, FF = 2816, NUP = 2 * FF, NQKV = 3 * DM;
constexpr float QSCALE = 0.125f * 1.4426950408889634f;
constexpr float LAMBDA_INIT = 0.35550906f;
constexpr size_t MiB = 1u << 20;
constexpr size_t WS_SSQ = 256 * 1024;
constexpr size_t WS_ROPE = 1 * MiB;
constexpr size_t WS_WIN = 2 * MiB;
constexpr size_t WS_WOUT = 46 * MiB;
constexpr size_t WS_WQKV = 68 * MiB;
constexpr size_t WS_WO = 80 * MiB;
constexpr size_t WS_XA = 84 * MiB;
constexpr size_t WS_H = 116 * MiB;
constexpr size_t WS_Q = 116 * MiB, WS_K = 148 * MiB, WS_V = 180 * MiB;
constexpr size_t WS_O = 212 * MiB;
constexpr size_t WS_T = 244 * MiB;
constexpr size_t WS_END = 308 * MiB;
constexpr int LDS_BYTES = 147456;
constexpr int NPHASE = 16;

#define GAS __attribute__((address_space(1)))
#define LAS __attribute__((address_space(3)))
typedef unsigned short bf16;
typedef unsigned v4u __attribute__((ext_vector_type(4)));
typedef float f32x4 __attribute__((ext_vector_type(4)));
__device__ __forceinline__ unsigned f2bf(float f) { unsigned u = __builtin_bit_cast(unsigned, f); return (u + 0x7fffu + ((u >> 16) & 1u)) >> 16; }
__device__ __forceinline__ unsigned pk2(float lo, float hi) { return f2bf(lo) | (f2bf(hi) << 16); }
__device__ __forceinline__ float bflo(unsigned u) { return __uint_as_float(u << 16); }
__device__ __forceinline__ float bfhi(unsigned u) { return __uint_as_float(u & 0xffff0000u); }
__device__ __forceinline__ int tid_opaque() { int t = threadIdx.x; asm volatile("" : "+v"(t)); return t; }
__device__ __forceinline__ int bid_opaque() { int t = blockIdx.x; asm volatile("" : "+s"(t)); return t; }
__device__ __forceinline__ float wave_sum(float v) {
#pragma unroll
    for (int o = 1; o < 64; o <<= 1) v += __shfl_xor(v, o);
    return v;
}

struct Args { const float* x; const float* ng; const float* fg; const float* w_in; const float* w_out; const float* sb_qkv; const float* sb_o;
              const float* df_qkv; const float* df_o; const float* df_lam; const float* df_sub; float* out; unsigned char* ws; int ph_lo, ph_hi; };

__device__ __forceinline__ int dst_row(int mode, int n) {
    if (mode == 1) { const int isu = n >= FF ? 1 : 0, j = n - isu * FF; return 256 * (j >> 7) + 128 * isu + (j & 127); }
    if (mode == 2) { if (n < 2048) { const int d = n & 63; return (n & ~63) + (d < 32 ? 2 * d : 2 * (d - 32) + 1); } return n; }
    return n;
}
__device__ __forceinline__ void transpose_item(const float* W, int K, int N, bf16* WT, int mode, LAS float* scr, int item, int lane) {
    const int nblk = N / 32, kb = item / nblk, nb = item % nblk, k0 = 64 * kb, n0 = 32 * nb;
#pragma unroll 8
    for (int i = 0; i < 32; ++i) { const int kk = 2 * i + (lane >> 5); scr[kk * 33 + (lane & 31)] = W[(size_t)(k0 + kk) * N + n0 + (lane & 31)]; }
    asm volatile("s_waitcnt lgkmcnt(0)" ::: "memory");
    const int c = lane & 7;
#pragma unroll
    for (int j = 0; j < 4; ++j) { const int n = (lane >> 3) + 8 * j; const LAS float* s = scr + (8 * c) * 33 + n;
        v4u o; o.x = pk2(s[0 * 33], s[1 * 33]); o.y = pk2(s[2 * 33], s[3 * 33]); o.z = pk2(s[4 * 33], s[5 * 33]); o.w = pk2(s[6 * 33], s[7 * 33]);
        *(v4u*)(WT + (size_t)dst_row(mode, n0 + n) * K + k0 + 8 * c) = o; }
    asm volatile("s_waitcnt lgkmcnt(0)" ::: "memory");
}
__device__ __forceinline__ void prologue(const Args& a, LAS unsigned char* lds) {
    const int tid = tid_opaque(), lane = tid & 63, wave = tid >> 6; const int bid = bid_opaque();
    LAS float* scr = (LAS float*)(lds + wave * 16384);
    const int gw = bid * 8 + wave, NGW = gridDim.x * 8;
    unsigned char* ws = a.ws;
    for (int mi = 0; mi < 12; ++mi) {
        const float* W; bf16* WT; int K, N, mode;
        if (mi < 4) { W = a.w_in + (size_t)mi * DM * NUP; WT = (bf16*)(ws + WS_WIN) + (size_t)mi * NUP * DM; K = DM; N = NUP; mode = 1; }
        else if (mi < 8) { W = a.w_out + (size_t)(mi - 4) * FF * DM; WT = (bf16*)(ws + WS_WOUT) + (size_t)(mi - 4) * DM * FF; K = FF; N = DM; mode = 0; }
        else if (mi == 8) { W = a.sb_qkv; WT = (bf16*)(ws + WS_WQKV); K = DM; N = NQKV; mode = 0; }
        else if (mi == 9) { W = a.df_qkv; WT = (bf16*)(ws + WS_WQKV) + (size_t)NQKV * DM; K = DM; N = NQKV; mode = 2; }
        else if (mi == 10) { W = a.sb_o; WT = (bf16*)(ws + WS_WO); K = DM; N = DM; mode = 0; }
        else { W = a.df_o; WT = (bf16*)(ws + WS_WO) + (size_t)DM * DM; K = DM; N = DM; mode = 0; }
        const int nit = (K / 64) * (N / 32);
        for (int it = gw; it < nit; it += NGW) transpose_item(W, K, N, WT, mode, scr, it, lane);
    }
    float* ssq = (float*)(ws + WS_SSQ); bf16* XA = (bf16*)(ws + WS_XA);
    f32x4 gv[4];
#pragma unroll
    for (int j = 0; j < 4; ++j) gv[j] = *((const f32x4*)a.ng + lane + 64 * j);
    for (int m = gw; m < M; m += NGW) {
        const f32x4* xr = (const f32x4*)(a.x + (size_t)m * DM) + lane; f32x4 v[4]; float s = 0.f;
#pragma unroll
        for (int j = 0; j < 4; ++j) { v[j] = xr[64 * j]; s += (v[j][0] * v[j][0] + v[j][1] * v[j][1]) + (v[j][2] * v[j][2] + v[j][3] * v[j][3]); }
        s = wave_sum(s);
        if (lane == 0) ssq[m] = s;
        unsigned long long* o8 = (unsigned long long*)(XA + (size_t)m * DM) + lane;
#pragma unroll
        for (int j = 0; j < 4; ++j) { const f32x4 t = v[j] * gv[j]; o8[64 * j] = (unsigned long long)pk2(t[0], t[1]) | ((unsigned long long)pk2(t[2], t[3]) << 32); }
    }
    const int gt = bid * 512 + tid, NGT = gridDim.x * 512;
    for (int i = gt; i < 6 * M; i += NGT) ssq[M + i] = 0.f;
    float* rc = (float*)(ws + WS_ROPE); float* rsn = rc + 2048 * 32;
    for (int i = gt; i < 2048 * 32; i += NGT) { const int pos = i >> 5, fi = i & 31;
        const float inv = __builtin_amdgcn_exp2f(-(float)fi * (13.287712379549449f / 32.0f));
        const float ang = (float)pos * inv;
        const double rev = (double)ang * 0.15915494309189535; const float fr = (float)(rev - rint(rev));
        rc[i] = __builtin_amdgcn_cosf(fr); rsn[i] = __builtin_amdgcn_sinf(fr); }
}
__device__ __forceinline__ void final_norm(const Args& a) {
    const int tid = tid_opaque(), lane = tid & 63, wave = tid >> 6; const int bid = bid_opaque();
    const int gw = bid * 8 + wave, NGW = gridDim.x * 8;
    const float* ssq = (const float*)(a.ws + WS_SSQ) + 6 * M;
    f32x4 gv[4];
#pragma unroll
    for (int j = 0; j < 4; ++j) gv[j] = *((const f32x4*)a.fg + lane + 64 * j);
    for (int m = gw; m < M; m += NGW) { const float rs = pg8::rstd_of(ssq[m]); f32x4* xr = (f32x4*)(a.out + (size_t)m * DM) + lane;
#pragma unroll
        for (int j = 0; j < 4; ++j) xr[64 * j] = xr[64 * j] * rs * gv[j]; }
}

__device__ __forceinline__ void sb_attn_naive(const bf16* Q, const bf16* K, const bf16* V, bf16* O) {
    const int tidn = tid_opaque();
    for (int it = bid_opaque(); it < 512; it += gridDim.x) {
        const int bh = it & 127, qb = 3 - (it >> 7), b = bh >> 4, h = bh & 15;
        const int t = qb * 512 + tidn;
        const uint4* qp = (const uint4*)(Q + ((size_t)(b * SEQ + t)) * DM + h * 64);
        float q[64], o[64];
#pragma unroll
        for (int j = 0; j < 8; ++j) { const uint4 w = qp[j]; q[8 * j] = bflo(w.x); q[8 * j + 1] = bfhi(w.x); q[8 * j + 2] = bflo(w.y); q[8 * j + 3] = bfhi(w.y); q[8 * j + 4] = bflo(w.z); q[8 * j + 5] = bfhi(w.z); q[8 * j + 6] = bflo(w.w); q[8 * j + 7] = bfhi(w.w); }
#pragma unroll
        for (int d = 0; d < 64; ++d) o[d] = 0.f;
        float R = 0.f;
        for (int s = qb * 512 + 511; s >= 0; --s) {
            const uint4* kp = (const uint4*)(K + ((size_t)(b * SEQ + s)) * DM + h * 64);
            float z = 0.f;
#pragma unroll
            for (int j = 0; j < 8; ++j) { const uint4 w = kp[j]; z += q[8 * j] * bflo(w.x) + q[8 * j + 1] * bfhi(w.x) + q[8 * j + 2] * bflo(w.y) + q[8 * j + 3] * bfhi(w.y) + q[8 * j + 4] * bflo(w.z) + q[8 * j + 5] * bfhi(w.z) + q[8 * j + 6] * bflo(w.w) + q[8 * j + 7] * bfhi(w.w); }
            if (s < t) {
                const float sp = fmaxf(z, 0.f) + __builtin_amdgcn_logf(1.0f + __builtin_amdgcn_exp2f(-fabsf(z)));
                const float aw = __builtin_amdgcn_exp2f((z - sp) + R);
                R -= sp;
                const bf16* vp = V + ((size_t)(b * 1024 + h * 64)) * SEQ + s;
#pragma unroll
                for (int d = 0; d < 64; ++d) o[d] += aw * bflo((unsigned)vp[(size_t)d * SEQ]);
            }
        }
        uint4* op = (uint4*)(O + ((size_t)(b * SEQ + t)) * DM + h * 64);
#pragma unroll
        for (int j = 0; j < 8; ++j) { uint4 w; w.x = pk2(o[8 * j], o[8 * j + 1]); w.y = pk2(o[8 * j + 2], o[8 * j + 3]); w.z = pk2(o[8 * j + 4], o[8 * j + 5]); w.w = pk2(o[8 * j + 6], o[8 * j + 7]); op[j] = w; }
    }
}
__device__ __forceinline__ float diff_lambda(const float* lp) {
    float s1 = 0.f, s2 = 0.f;
    for (int i = 0; i < 64; ++i) { s1 += lp[i] * lp[64 + i]; s2 += lp[128 + i] * lp[192 + i]; }
    return expf(s1) - expf(s2) + LAMBDA_INIT;
}
__device__ __forceinline__ void diff_attn_naive(const bf16* Q, const bf16* K, const bf16* V, bf16* O, float* T, const float* lamp, const float* subg) {
    const float lam = diff_lambda(lamp);
    const int tidn = tid_opaque();
    for (int it = bid_opaque(); it < 256; it += gridDim.x) {
        const int bh = it & 63, qb = 3 - (it >> 6), b = bh >> 3, h = bh & 7;
        const int t = qb * 512 + tidn, kend = ((t >> 6) + 1) << 6;
        float* Tr = T + ((size_t)(b * SEQ + t)) * DM + h * 128;
        for (int vh = 0; vh < 2; ++vh)
            for (int mp = 0; mp < 2; ++mp) {
                const uint4* qp = (const uint4*)(Q + ((size_t)(b * SEQ + t)) * DM + (h * 2 + mp) * 64);
                float q[64], o[64];
#pragma unroll
                for (int j = 0; j < 8; ++j) { const uint4 w = qp[j]; q[8 * j] = bflo(w.x); q[8 * j + 1] = bfhi(w.x); q[8 * j + 2] = bflo(w.y); q[8 * j + 3] = bfhi(w.y); q[8 * j + 4] = bflo(w.z); q[8 * j + 5] = bfhi(w.z); q[8 * j + 6] = bflo(w.w); q[8 * j + 7] = bfhi(w.w); }
#pragma unroll
                for (int d = 0; d < 64; ++d) o[d] = 0.f;
                float mx = -1e30f, l = 0.f;
                for (int s = 0; s < qb * 512 + 512; ++s) {
                    const uint4* kp = (const uint4*)(K + ((size_t)(b * SEQ + s)) * DM + (h * 2 + mp) * 64);
                    float z = 0.f;
#pragma unroll
                    for (int j = 0; j < 8; ++j) { const uint4 w = kp[j]; z += q[8 * j] * bflo(w.x) + q[8 * j + 1] * bfhi(w.x) + q[8 * j + 2] * bflo(w.y) + q[8 * j + 3] * bfhi(w.y) + q[8 * j + 4] * bflo(w.z) + q[8 * j + 5] * bfhi(w.z) + q[8 * j + 6] * bflo(w.w) + q[8 * j + 7] * bfhi(w.w); }
                    if (s < kend) {
                        const float mn = fmaxf(mx, z), f = __builtin_amdgcn_exp2f(mx - mn), p = __builtin_amdgcn_exp2f(z - mn);
                        mx = mn; l = l * f + p;
                        const bf16* vp = V + ((size_t)(b * 1024 + h * 128 + vh * 64)) * SEQ + s;
#pragma unroll
                        for (int d = 0; d < 64; ++d) o[d] = o[d] * f + p * bflo((unsigned)vp[(size_t)d * SEQ]);
                    }
                }
                const float il = 1.0f / l;
                if (mp == 0) {
#pragma unroll
                    for (int d = 0; d < 64; d += 4) *(f32x4*)(Tr + vh * 64 + d) = (f32x4){o[d] * il, o[d + 1] * il, o[d + 2] * il, o[d + 3] * il};
                } else {
#pragma unroll
                    for (int d = 0; d < 64; d += 4) { const f32x4 p1 = *(const f32x4*)(Tr + vh * 64 + d);
                        *(f32x4*)(Tr + vh * 64 + d) = (f32x4){p1[0] - lam * o[d] * il, p1[1] - lam * o[d + 1] * il, p1[2] - lam * o[d + 2] * il, p1[3] - lam * o[d + 3] * il}; }
                }
            }
        float ss = 0.f;
        for (int d = 0; d < 128; d += 4) { const f32x4 v = *(const f32x4*)(Tr + d); ss += (v[0] * v[0] + v[1] * v[1]) + (v[2] * v[2] + v[3] * v[3]); }
        const float rs = (1.0f / sqrtf(ss * (1.0f / 128.0f) + 1e-6f)) * (1.0f - LAMBDA_INIT);
        bf16* Or = O + ((size_t)(b * SEQ + t)) * DM + h * 128;
        for (int d = 0; d < 128; d += 4) { const f32x4 v = *(const f32x4*)(Tr + d); const f32x4 g = *(const f32x4*)(subg + d);
            uint2 w; w.x = pk2(v[0] * rs * g[0], v[1] * rs * g[1]); w.y = pk2(v[2] * rs * g[2], v[3] * rs * g[3]); *(uint2*)(Or + d) = w; }
    }
}
typedef short a_bf16x8 __attribute__((ext_vector_type(8)));
typedef short a_s16x4 __attribute__((ext_vector_type(4)));
typedef _Float16 a_f16x8 __attribute__((ext_vector_type(8)));
typedef float a_f32x16 __attribute__((ext_vector_type(16)));
#define A_LDS_BARRIER() asm volatile("s_waitcnt lgkmcnt(0)\n\ts_barrier" ::: "memory")
#define A_SBAR() __builtin_amdgcn_sched_barrier(0)
__device__ __forceinline__ float a_max(float x, float y) { float r; asm("v_max_f32_e32 %0, %1, %2" : "=v"(r) : "v"(x), "v"(y)); return r; }
__device__ __forceinline__ float a_max3(float x, float y, float z) { float r; asm("v_max3_f32 %0, %1, %2, %3" : "=v"(r) : "v"(x), "v"(y), "v"(z)); return r; }
__device__ __forceinline__ float a_pair_max(float m) { auto rr = __builtin_amdgcn_permlane32_swap(__float_as_uint(m), __float_as_uint(m), false, false); return a_max(__uint_as_float(rr[0]), __uint_as_float(rr[1])); }
__device__ __forceinline__ float a_pair_sum(float m) { auto rr = __builtin_amdgcn_permlane32_swap(__float_as_uint(m), __float_as_uint(m), false, false); return __uint_as_float(rr[0]) + __uint_as_float(rr[1]); }
__device__ __forceinline__ float a_lo_bcast(float m) { auto rr = __builtin_amdgcn_permlane32_swap(__float_as_uint(m), __float_as_uint(m), false, false); return __uint_as_float(rr[0]); }
__device__ __forceinline__ void a_stage_vt(LAS unsigned char* vb, int cs, int row, int sch, v4u v) { typedef unsigned u2 __attribute__((ext_vector_type(2)));
    LAS unsigned char* p = vb + (sch >> 1) * 2 * cs + row * 16 + 8 * (sch & 1); *(LAS u2*)(p) = (u2){v.x, v.y}; *(LAS u2*)(p + cs) = (u2){v.z, v.w}; }
constexpr int SB_CS = 1152, DF_CSV = 2176;
__device__ __forceinline__ int crow(int r, int hi) { return (r & 3) + 8 * (r >> 2) + 4 * hi; }
__device__ __forceinline__ unsigned a_cvtpk(float lo, float hi) { typedef float f2 __attribute__((ext_vector_type(2))); typedef __bf16 b2 __attribute__((ext_vector_type(2))); f2 v = {lo, hi}; b2 b = __builtin_convertvector(v, b2); return __builtin_bit_cast(unsigned, b); }
#define A_PACK_BF16(P0, P1, PW) do { \
    PW[0] = __builtin_bit_cast(a_bf16x8, (v4u){a_cvtpk(P0[0], P0[1]), a_cvtpk(P0[2], P0[3]), a_cvtpk(P0[4], P0[5]), a_cvtpk(P0[6], P0[7])}); \
    PW[1] = __builtin_bit_cast(a_bf16x8, (v4u){a_cvtpk(P0[8], P0[9]), a_cvtpk(P0[10], P0[11]), a_cvtpk(P0[12], P0[13]), a_cvtpk(P0[14], P0[15])}); \
    PW[2] = __builtin_bit_cast(a_bf16x8, (v4u){a_cvtpk(P1[0], P1[1]), a_cvtpk(P1[2], P1[3]), a_cvtpk(P1[4], P1[5]), a_cvtpk(P1[6], P1[7])}); \
    PW[3] = __builtin_bit_cast(a_bf16x8, (v4u){a_cvtpk(P1[8], P1[9]), a_cvtpk(P1[10], P1[11]), a_cvtpk(P1[12], P1[13]), a_cvtpk(P1[14], P1[15])}); } while (0)

__device__ __forceinline__ void sb_attn(const bf16* Q, const bf16* K, const bf16* VT, bf16* O, LAS unsigned char* lds) {
    const int tid = tid_opaque(), lane = tid & 63, r32 = lane & 31, hi = lane >> 5, wid = __builtin_amdgcn_readfirstlane(tid >> 6);
    const int c = bid_opaque(), G = gridDim.x;
    a_f16x8 TA0, TA1, ONES;
#pragma unroll
    for (int e = 0; e < 8; ++e) { const int kin = 4 * hi + (e & 3) + 8 * (e >> 2); TA0[e] = (kin > r32) ? (_Float16)1.0f : (_Float16)0.0f; TA1[e] = (16 + kin > r32) ? (_Float16)1.0f : (_Float16)0.0f; ONES[e] = (_Float16)1.0f; }
    for (int u = c; u < 1024; u += G) {
        const int cc = u & 255, ui = u >> 8, bh = cc >> 1, sg = cc & 1;
        const int qb = (ui == 0) ? 7 - sg : (ui == 1) ? sg : (ui == 2) ? 5 - sg : 2 + sg;
        const int b = bh >> 4, h = bh & 15;
        const int q0 = qb * 256 + wid * 32, td = q0 >> 6, Tmax = qb * 4 + 3, qloc = (q0 & 63) + r32;
        const bf16* Qw = Q + ((size_t)(b * SEQ + q0 + r32)) * DM + h * 64 + hi * 8;
        a_bf16x8 qr[4];
#pragma unroll
        for (int d0 = 0; d0 < 4; ++d0) qr[d0] = *(const a_bf16x8*)(Qw + d0 * 16);
        a_f32x16 ot[2]; ot[0] = (a_f32x16){}; ot[1] = (a_f32x16){};
        float R = 0.f;
        const int srow = tid >> 3, sch = tid & 7, sdst = sch * SB_CS + srow * 16;
        const bf16* kg = K + ((size_t)(b * SEQ + srow)) * DM + h * 64 + sch * 8;
        const bf16* vg = VT + ((size_t)(b * 1024 + h * 64 + srow)) * SEQ + sch * 8;
        v4u kreg = *(const v4u*)(kg + (size_t)Tmax * 64 * DM), vreg = *(const v4u*)(vg + Tmax * 64);
        LAS int* dflag = (LAS int*)(lds + 40960) + (ui & 1) * 8;
        if (lane == 0) dflag[wid] = -1;
        bool fin = false;
        for (int t = Tmax; t >= 0; --t) {
            LAS unsigned char* kb = lds + ((Tmax - t) & 1) * (2 * 8 * SB_CS); LAS unsigned char* vb = kb + 8 * SB_CS;
            *(LAS v4u*)(kb + sdst) = kreg; a_stage_vt(vb, SB_CS, srow, sch, vreg);
            if (t > 0) { kreg = *(const v4u*)(kg + (size_t)(t - 1) * 64 * DM); vreg = *(const v4u*)(vg + (t - 1) * 64); }
            A_LDS_BARRIER();
            { const int dv = dflag[lane & 7]; if (__all(dv > t)) break; }
            if (t <= td && !fin) {
                a_bf16x8 kf[8];
#pragma unroll
                for (int d0 = 0; d0 < 4; ++d0) { kf[2 * d0] = *(const LAS a_bf16x8*)(kb + (2 * d0 + hi) * SB_CS + r32 * 16); kf[2 * d0 + 1] = *(const LAS a_bf16x8*)(kb + (2 * d0 + hi) * SB_CS + 512 + r32 * 16); }
                a_f32x16 p0 = (a_f32x16){}, p1 = (a_f32x16){};
#pragma unroll
                for (int d0 = 0; d0 < 4; ++d0) { p0 = __builtin_amdgcn_mfma_f32_32x32x16_bf16(kf[2 * d0], qr[d0], p0, 0, 0, 0); p1 = __builtin_amdgcn_mfma_f32_32x32x16_bf16(kf[2 * d0 + 1], qr[d0], p1, 0, 0, 0); }
                a_bf16x8 vf[8];
#pragma unroll
                for (int blk = 0; blk < 2; ++blk)
#pragma unroll
                    for (int j = 0; j < 4; ++j) vf[blk * 4 + j] = *(const LAS a_bf16x8*)(vb + (2 * j + hi) * SB_CS + (32 * blk + r32) * 16);
                A_SBAR();
                const bool diag = (t == td);
                float lv0[16], lv1[16];
#pragma unroll
                for (int r = 0; r < 16; ++r) {
                    { const float z = p0[r], uu = __builtin_amdgcn_logf(1.0f + __builtin_amdgcn_exp2f(-fabsf(z))); float sp = a_max(z, 0.f) + uu, ls = z - sp;
                      if (diag && crow(r, hi) >= qloc) { sp = 0.f; ls = -__builtin_inff(); } p0[r] = ls; lv0[r] = -sp; }
                    { const float z = p1[r], uu = __builtin_amdgcn_logf(1.0f + __builtin_amdgcn_exp2f(-fabsf(z))); float sp = a_max(z, 0.f) + uu, ls = z - sp;
                      if (diag && 32 + crow(r, hi) >= qloc) { sp = 0.f; ls = -__builtin_inff(); } p1[r] = ls; lv1[r] = -sp; }
                }
                a_f16x8 lw[4];
#pragma unroll
                for (int e = 0; e < 8; ++e) { lw[0][e] = (_Float16)lv0[e]; lw[1][e] = (_Float16)lv0[8 + e]; lw[2][e] = (_Float16)lv1[e]; lw[3][e] = (_Float16)lv1[8 + e]; }
                a_f32x16 s0, s1;
#pragma unroll
                for (int r = 0; r < 16; ++r) { s0[r] = R; s1[r] = R; }
                s0 = __builtin_amdgcn_mfma_f32_32x32x16_f16(TA0, lw[0], s0, 0, 0, 0); s1 = __builtin_amdgcn_mfma_f32_32x32x16_f16(TA0, lw[2], s1, 0, 0, 0);
                s0 = __builtin_amdgcn_mfma_f32_32x32x16_f16(TA1, lw[1], s0, 0, 0, 0); s1 = __builtin_amdgcn_mfma_f32_32x32x16_f16(TA1, lw[3], s1, 0, 0, 0);
                s0 = __builtin_amdgcn_mfma_f32_32x32x16_f16(ONES, lw[2], s0, 0, 0, 0); s0 = __builtin_amdgcn_mfma_f32_32x32x16_f16(ONES, lw[3], s0, 0, 0, 0);
                R = a_lo_bcast(s0[0] + lv0[0]);
#pragma unroll
                for (int r = 0; r < 16; ++r) { p0[r] = __builtin_amdgcn_exp2f(p0[r] + s0[r]); p1[r] = __builtin_amdgcn_exp2f(p1[r] + s1[r]); }
                a_bf16x8 pw[4]; A_PACK_BF16(p0, p1, pw);
                A_SBAR();
#pragma unroll
                for (int j = 0; j < 4; ++j)
#pragma unroll
                    for (int blk = 0; blk < 2; ++blk) ot[blk] = __builtin_amdgcn_mfma_f32_32x32x16_bf16(vf[blk * 4 + j], pw[j], ot[blk], 0, 0, 0);
                if (__all(R < -150.0f)) { fin = true; if (lane == 0) dflag[wid] = t; }
            }
        }
        bf16* Ow = O + ((size_t)(b * SEQ + q0 + r32)) * DM + h * 64 + 4 * hi;
#pragma unroll
        for (int blk = 0; blk < 2; ++blk)
#pragma unroll
            for (int g = 0; g < 4; ++g) { uint2 w; w.x = a_cvtpk(ot[blk][4 * g], ot[blk][4 * g + 1]); w.y = a_cvtpk(ot[blk][4 * g + 2], ot[blk][4 * g + 3]); *(uint2*)(Ow + 32 * blk + 8 * g) = w; }
    }
}

__device__ __forceinline__ void diff_attn(const bf16* Q, const bf16* K, const bf16* VT, bf16* O, const float* lamp, const float* subg, LAS unsigned char* lds) {
    const int tid = tid_opaque(), lane = tid & 63, r32 = lane & 31, hi = lane >> 5, wid = __builtin_amdgcn_readfirstlane(tid >> 6), mp = wid >> 2, w4 = wid & 3;
    const int c = bid_opaque(), G = gridDim.x;
    const float lam = diff_lambda(lamp);
    constexpr int DF_STAGE = 16 * SB_CS + 8 * DF_CSV;
    LAS float* ex = (LAS float*)(lds + 2 * DF_STAGE);
    for (int u = c; u < 1024; u += G) {
        const int cc = u & 255, ui = u >> 8, bh = cc >> 2, sg = cc & 3;
        const int qb = (ui == 0) ? 15 - sg : (ui == 1) ? 8 + sg : (ui == 2) ? 7 - sg : sg;
        const int b = bh >> 3, h = bh & 7;
        const int q0 = qb * 128 + w4 * 32, tdw = q0 >> 6, Tmax = qb * 2 + 1;
        const bf16* Qw = Q + ((size_t)(b * SEQ + q0 + r32)) * DM + (h * 2 + mp) * 64 + hi * 8;
        a_bf16x8 qr[4];
#pragma unroll
        for (int d0 = 0; d0 < 4; ++d0) qr[d0] = *(const a_bf16x8*)(Qw + d0 * 16);
        a_f32x16 ot[4];
#pragma unroll
        for (int i = 0; i < 4; ++i) ot[i] = (a_f32x16){};
        float mx = -1e30f, l = 0.f;
        const int srow = tid >> 3, sch = tid & 7;
        const bf16* kg = K + ((size_t)(b * SEQ + srow)) * DM + h * 128 + sch * 8;
        const bf16* vg = VT + ((size_t)(b * 1024 + h * 128 + srow)) * SEQ + sch * 8;
        v4u k1r = *(const v4u*)(kg), k2r = *(const v4u*)(kg + 64), v1r = *(const v4u*)(vg), v2r = *(const v4u*)(vg + 64 * SEQ);
        for (int t = 0; t <= Tmax; ++t) {
            LAS unsigned char* base = lds + (t & 1) * DF_STAGE;
            *(LAS v4u*)(base + sch * SB_CS + srow * 16) = k1r; *(LAS v4u*)(base + 8 * SB_CS + sch * SB_CS + srow * 16) = k2r;
            a_stage_vt(base + 16 * SB_CS, DF_CSV, srow, sch, v1r); a_stage_vt(base + 16 * SB_CS, DF_CSV, srow + 64, sch, v2r);
            if (t < Tmax) { const size_t ko = (size_t)(t + 1) * 64 * DM; const int vo = (t + 1) * 64;
                k1r = *(const v4u*)(kg + ko); k2r = *(const v4u*)(kg + ko + 64); v1r = *(const v4u*)(vg + vo); v2r = *(const v4u*)(vg + vo + 64 * SEQ); }
            A_LDS_BARRIER();
            if (t <= tdw) {
                LAS unsigned char* kb = base + mp * 8 * SB_CS; LAS unsigned char* vb = base + 16 * SB_CS;
                a_bf16x8 kf[8];
#pragma unroll
                for (int d0 = 0; d0 < 4; ++d0) { kf[2 * d0] = *(const LAS a_bf16x8*)(kb + (2 * d0 + hi) * SB_CS + r32 * 16); kf[2 * d0 + 1] = *(const LAS a_bf16x8*)(kb + (2 * d0 + hi) * SB_CS + 512 + r32 * 16); }
                a_f32x16 p0 = (a_f32x16){}, p1 = (a_f32x16){};
#pragma unroll
                for (int d0 = 0; d0 < 4; ++d0) { p0 = __builtin_amdgcn_mfma_f32_32x32x16_bf16(kf[2 * d0], qr[d0], p0, 0, 0, 0); p1 = __builtin_amdgcn_mfma_f32_32x32x16_bf16(kf[2 * d0 + 1], qr[d0], p1, 0, 0, 0); }
                a_bf16x8 vf[16];
#pragma unroll
                for (int blk = 0; blk < 4; ++blk)
#pragma unroll
                    for (int j = 0; j < 4; ++j) vf[blk * 4 + j] = *(const LAS a_bf16x8*)(vb + (2 * j + hi) * DF_CSV + (32 * blk + r32) * 16);
                A_SBAR();
                float rm = a_max3(p0[0], p1[0], p0[1]);
#pragma unroll
                for (int r = 1; r < 15; ++r) rm = a_max3(rm, p1[r], p0[r + 1]);
                rm = a_pair_max(a_max(rm, p1[15]));
                if (__any(rm > mx)) { const float mn = a_max(mx, rm), f = __builtin_amdgcn_exp2f(mx - mn); mx = mn; l *= f;
#pragma unroll
                    for (int i = 0; i < 4; ++i) ot[i] = ot[i] * f; }
                float ps = 0.f;
#pragma unroll
                for (int r = 0; r < 16; ++r) { p0[r] = __builtin_amdgcn_exp2f(p0[r] - mx); p1[r] = __builtin_amdgcn_exp2f(p1[r] - mx); ps += p0[r] + p1[r]; }
                l += ps;
                a_bf16x8 pw[4]; A_PACK_BF16(p0, p1, pw);
                A_SBAR();
#pragma unroll
                for (int j = 0; j < 4; ++j)
#pragma unroll
                    for (int blk = 0; blk < 4; ++blk) ot[blk] = __builtin_amdgcn_mfma_f32_32x32x16_bf16(vf[blk * 4 + j], pw[j], ot[blk], 0, 0, 0);
            }
        }
        const float il = 1.0f / a_pair_sum(l);
        if (mp == 1) {
#pragma unroll
            for (int blk = 0; blk < 4; ++blk)
#pragma unroll
                for (int r = 0; r < 16; ++r) ex[((w4 * 4 + blk) * 16 + r) * 64 + lane] = ot[blk][r] * il;
        }
        __syncthreads();
        if (mp == 0) {
            float ss = 0.f;
#pragma unroll
            for (int blk = 0; blk < 4; ++blk)
#pragma unroll
                for (int r = 0; r < 16; ++r) { const float o = ot[blk][r] * il - lam * ex[((w4 * 4 + blk) * 16 + r) * 64 + lane]; ot[blk][r] = o; ss += o * o; }
            ss = a_pair_sum(ss);
            const float rs = (1.0f / sqrtf(ss * (1.0f / 128.0f) + 1e-6f)) * (1.0f - LAMBDA_INIT);
            bf16* Ow = O + ((size_t)(b * SEQ + q0 + r32)) * DM + h * 128 + 4 * hi;
#pragma unroll
            for (int blk = 0; blk < 4; ++blk)
#pragma unroll
                for (int g = 0; g < 4; ++g) { const f32x4 gg = *(const f32x4*)(subg + 32 * blk + 8 * g + 4 * hi);
                    uint2 w; w.x = a_cvtpk(ot[blk][4 * g] * rs * gg[0], ot[blk][4 * g + 1] * rs * gg[1]); w.y = a_cvtpk(ot[blk][4 * g + 2] * rs * gg[2], ot[blk][4 * g + 3] * rs * gg[3]);
                    *(uint2*)(Ow + 32 * blk + 8 * g) = w; }
        }
    }
}
#define XB_TMO      128
#define XB_XCNT(j)  (256  + 64 * (j))
#define XB_XSUB(j)  (1280 + 64 * (j))
#define XB_XGEN(j)  (2304 + 64 * (j))
#define XB_TOP      3328
#define XB_TOPGEN   3392
#define XCD_BAR_WORDS 3456
#define XB_SPIN_CAP (1u << 18)

__device__ __forceinline__ unsigned xb_ld(unsigned* p)              { return __hip_atomic_load(p, __ATOMIC_RELAXED, __HIP_MEMORY_SCOPE_AGENT); }
__device__ __forceinline__ unsigned xb_add(unsigned* p, unsigned v) { return __hip_atomic_fetch_add(p, v, __ATOMIC_RELAXED, __HIP_MEMORY_SCOPE_AGENT); }
__device__ __forceinline__ unsigned xb_xcc_id() { return (unsigned)__builtin_amdgcn_s_getreg((3 << 11) | 20) & 0xFu; }
#define XB_SPIN(cond, bar) do { unsigned _sp = 0; while (cond) { __builtin_amdgcn_s_sleep(1); \
    if ((++_sp & 255u) == 0u) { if (xb_ld(&(bar)[XB_TMO])) break; if (_sp > XB_SPIN_CAP) { atomicAdd(&(bar)[XB_TMO], 1u); break; } } } } while (0)

struct XcdBarrier {
    unsigned* bar; unsigned x;
    volatile LAS unsigned* st;
};

__device__ __forceinline__ XcdBarrier xcd_barrier_post(unsigned* bar, volatile LAS unsigned* st) {
    XcdBarrier b; b.bar = bar; b.x = xb_xcc_id(); b.st = st;
    if (threadIdx.x == 0) (void)xb_add(&bar[XB_XCNT(b.x)], 1u);
    return b;
}
__device__ __forceinline__ void xcd_barrier_complete(unsigned* bar, unsigned x, unsigned& nloc, unsigned& nx) {
    const unsigned G = gridDim.x * gridDim.y * gridDim.z;
    unsigned sum, cnt, mine, sp = 0u;
    for (;;) {
        sum = 0u; cnt = 0u; mine = 0u;
#pragma unroll
        for (unsigned j = 0; j < 16; ++j) { const unsigned c = xb_ld(&bar[XB_XCNT(j)]); sum += c; cnt += (c > 0u) ? 1u : 0u; mine = (j == x) ? c : mine; }
        if (sum == G) break;
        __builtin_amdgcn_s_sleep(1);
        if ((++sp & 255u) == 0u) { if (xb_ld(&bar[XB_TMO])) break; if (sp > XB_SPIN_CAP) { atomicAdd(&bar[XB_TMO], 1u); break; } }
    }
    nloc = mine > 0u ? mine : 1u; nx = cnt > 0u ? cnt : 1u;
}

__device__ __forceinline__ void xcd_barrier(const XcdBarrier& b) {
    asm volatile("s_waitcnt vmcnt(0)" ::: "memory");
    __syncthreads();
    if (threadIdx.x == 0) {
        unsigned* bar = b.bar;
        __builtin_amdgcn_s_waitcnt(0);
        unsigned nloc = b.st[0], nx = b.st[1];
        if (nloc == 0u) { xcd_barrier_complete(bar, b.x, nloc, nx); b.st[0] = nloc; b.st[1] = nx; }
        const unsigned old = xb_add(&bar[XB_XSUB(b.x)], 1u);
        const unsigned gen = old / nloc;
        if (old + 1u == (gen + 1u) * nloc) {
            __builtin_amdgcn_fence(__ATOMIC_RELEASE, "agent");
            asm volatile("s_waitcnt vmcnt(0)" ::: "memory");
            const unsigned og = xb_add(&bar[XB_TOP], 1u);
            const unsigned tg = og / nx;
            if (og + 1u == (tg + 1u) * nx) xb_add(&bar[XB_TOPGEN], 1u);
            else XB_SPIN(xb_ld(&bar[XB_TOPGEN]) == tg, bar);
            __builtin_amdgcn_fence(__ATOMIC_ACQUIRE, "agent");
            xb_add(&bar[XB_XGEN(b.x)], 1u);
            asm volatile("s_waitcnt vmcnt(0)" ::: "memory");
        } else {
            XB_SPIN(xb_ld(&bar[XB_XGEN(b.x)]) == gen, bar);
            __builtin_amdgcn_fence(__ATOMIC_ACQUIRE, "agent");
            asm volatile("s_waitcnt vmcnt(0)" ::: "memory");
        }
    }
    __syncthreads();
}
#ifndef MK_MULTI
#define MK_MULTI 0
#endif
__global__ void __launch_bounds__(512, 2) mega(Args a_in) {
    extern __shared__ __attribute__((aligned(16))) unsigned char lds_raw[];
    LAS unsigned char* lds = (LAS unsigned char*)lds_raw;
    cg::grid_group grid = cg::this_grid();
    const int ph_lo = a_in.ph_lo, ph_hi = a_in.ph_hi;
    volatile LAS unsigned* MISC = (volatile LAS unsigned*)(lds + LDS_BYTES - 128);
    if (threadIdx.x < 32) MISC[threadIdx.x] = 0u;
    __syncthreads();
    XcdBarrier bar = xcd_barrier_post((unsigned*)a_in.ws, MISC + 8);
    for (int p = ph_lo; p < ph_hi; ++p) {
#if defined(MK_REREAD)

    unsigned long long apv = (unsigned long long)__builtin_amdgcn_kernarg_segment_ptr();
    unsigned aplo = (unsigned)apv, aphi = (unsigned)(apv >> 32); asm volatile("" : "+s"(aplo), "+s"(aphi));
    aplo = __builtin_amdgcn_readfirstlane(aplo); aphi = __builtin_amdgcn_readfirstlane(aphi);
    const __attribute__((address_space(4))) unsigned char* ap = (const __attribute__((address_space(4))) unsigned char*)(((unsigned long long)aphi << 32) | aplo);
    Args a; __builtin_memcpy(&a, ap, sizeof(Args));
#else
    const Args a = a_in;
#endif
    unsigned char* ws = a.ws;
    float* ssq = (float*)(ws + WS_SSQ);
    bf16* XA = (bf16*)(ws + WS_XA); bf16* H = (bf16*)(ws + WS_H); bf16* Q = (bf16*)(ws + WS_Q); bf16* Kb = (bf16*)(ws + WS_K); bf16* Vb = (bf16*)(ws + WS_V); bf16* O = (bf16*)(ws + WS_O);
    const bf16* Win = (const bf16*)(ws + WS_WIN); const bf16* Wout = (const bf16*)(ws + WS_WOUT); const bf16* Wqkv = (const bf16*)(ws + WS_WQKV); const bf16* Wo = (const bf16*)(ws + WS_WO);
    const int G = gridDim.x, c = bid_opaque();
    {
        if (p == 0) {
#ifndef NO_PRO
 prologue(a, lds);
#if defined(PROBE_PRO2)
 __syncthreads(); prologue(a, lds);
#endif
#endif
 }
        else if (p == NPHASE - 1) final_norm(a);
        else {
            const int L = (p - 1) / 7, s = (p - 1) % 7;
            if (s == 0 || s == 5) {
                const int ab = (s == 5) ? 1 : 0;
                pg8::Gemm g{XA, Win + (size_t)(L * 2 + ab) * NUP * DM, M, NUP, DM}; pg8::StaticOrder S; S.init(M, NUP, G, c);
                pg8::EpiSwiglu E{H, ssq + (size_t)(3 * L + 2 * ab) * M, FF};

#ifndef NO_UP
 pg8::gemm_phase<pg8::EpiSwiglu, pg8::StaticOrder, true, true>(lds, g, S, E);
#if defined(PROBE_UP2)
 __syncthreads(); pg8::gemm_phase<pg8::EpiSwiglu, pg8::StaticOrder, true, true>(lds, g, S, E);
#endif
#endif

            } else if (s == 1 || s == 4 || s == 6) {
                const bf16* A; const bf16* Bt; int K; float alpha; int nn; const float* gain;
                if (s == 4) { A = O; Bt = Wo + (size_t)L * DM * DM; K = DM; alpha = 1.0f; nn = 3 * L + 2; gain = a.ng + (size_t)(3 * L + 2) * DM; }
                else if (s == 1) { A = H; Bt = Wout + (size_t)(L * 2) * DM * FF; K = FF; alpha = 0.5f; nn = 3 * L + 1; gain = a.ng + (size_t)(3 * L + 1) * DM; }
                else { A = H; Bt = Wout + (size_t)(L * 2 + 1) * DM * FF; K = FF; alpha = 0.5f; nn = 3 * L + 3; gain = (L == 1) ? a.fg : a.ng + (size_t)(3 * L + 3) * DM; }
                pg8::Gemm g{A, Bt, M, DM, K}; pg8::StaticOrder S; S.init(M, DM, G, c);
                pg8::EpiRes E{(p == 2) ? a.x : a.out, a.out, XA, gain, ssq + (size_t)nn * M, alpha};

#ifndef NO_RES
 pg8::gemm_phase<pg8::EpiRes, pg8::StaticOrder, true, true>(lds, g, S, E);
#endif

            } else if (s == 2) {
                pg8::Gemm g{XA, Wqkv + (size_t)L * NQKV * DM, M, NQKV, DM}; pg8::StaticOrder S; S.init(M, NQKV, G, c);
                const float* rc = (const float*)(ws + WS_ROPE);
                pg8::EpiQKV E{Q, (size_t)(WS_K - WS_Q) / 2, ssq + (size_t)(3 * L + 1) * M, QSCALE, L == 1 ? rc : nullptr, rc + 2048 * 32};

#ifndef NO_QKV
 pg8::gemm_phase<pg8::EpiQKV, pg8::StaticOrder, true, true>(lds, g, S, E);
#if defined(PROBE_QKV2)
 __syncthreads(); pg8::gemm_phase<pg8::EpiQKV, pg8::StaticOrder, true, true>(lds, g, S, E);
#endif
#endif

            } else {

#if defined(SB_NAIVE)
                if (L == 0) sb_attn_naive(Q, Kb, Vb, O);
#else
                if (L == 0) { sb_attn(Q, Kb, Vb, O, lds);
#if defined(PROBE_SB2)
 __syncthreads(); sb_attn(Q, Kb, Vb, O, lds);
#endif
 }
#endif
#if defined(DF_NAIVE)
                if (L == 1) diff_attn_naive(Q, Kb, Vb, O, (float*)(ws + WS_T), a.df_lam, a.df_sub);
#else
                if (L == 1) { diff_attn(Q, Kb, Vb, O, a.df_lam, a.df_sub, lds);
#if defined(PROBE_DF2)
 __syncthreads(); diff_attn(Q, Kb, Vb, O, a.df_lam, a.df_sub, lds);
#endif
 }
#endif

            }
        }
        if (p + 1 < ph_hi) {
#if defined(MK_ALL_CG)
            grid.sync();
#else
            if (p == 0) grid.sync(); else xcd_barrier(bar);
#endif
        }
    }
    }
}

extern "C" void kernel_launch(void* const* d_in, const int* in_sizes, int n_in, void* d_out, int out_size, void* d_ws, size_t ws_size, hipStream_t stream) {
    static int grid = 0;
    if (grid == 0) {
        if (n_in != 11 || in_sizes[0] != M * DM || out_size != M * DM || ws_size < WS_END) { fprintf(stderr, "kernel_launch: unexpected shapes (n_in %d, in0 %d, out %d, ws %zu)\n", n_in, n_in > 0 ? in_sizes[0] : -1, out_size, ws_size); grid = -1; return; }
        int dev = 0, cus = 0, per_cu = 0;
        if (hipGetDevice(&dev) != hipSuccess || hipDeviceGetAttribute(&cus, hipDeviceAttributeMultiprocessorCount, dev) != hipSuccess) { grid = -1; return; }
        if (hipFuncSetAttribute((const void*)mega, hipFuncAttributeMaxDynamicSharedMemorySize, LDS_BYTES) != hipSuccess) { fprintf(stderr, "kernel_launch: hipFuncSetAttribute failed\n"); grid = -1; return; }
        if (hipOccupancyMaxActiveBlocksPerMultiprocessor(&per_cu, (const void*)mega, 512, LDS_BYTES) != hipSuccess || per_cu < 1) { fprintf(stderr, "kernel_launch: occupancy query gave %d\n", per_cu); per_cu = 1; }
        (void)hipGetLastError();
        grid = cus * (per_cu > 1 ? 1 : per_cu);
    }
    if (grid < 0) return;
    if (hipMemsetAsync(d_ws, 0, 16384, stream) != hipSuccess) { fprintf(stderr, "kernel_launch: memset failed\n"); return; }
    Args a{};
    a.x = (const float*)d_in[0]; a.ng = (const float*)d_in[1]; a.fg = (const float*)d_in[2]; a.w_in = (const float*)d_in[3]; a.w_out = (const float*)d_in[4];
    a.sb_qkv = (const float*)d_in[5]; a.sb_o = (const float*)d_in[6]; a.df_qkv = (const float*)d_in[7]; a.df_o = (const float*)d_in[8]; a.df_lam = (const float*)d_in[9]; a.df_sub = (const float*)d_in[10];
    a.out = (float*)d_out; a.ws = (unsigned char*)d_ws;
#if MK_MULTI
    for (int p = 0; p < NPHASE; ++p) { a.ph_lo = p; a.ph_hi = p + 1; hipLaunchKernelGGL(mega, dim3(grid), dim3(512), LDS_BYTES, stream, a); }
#else
    a.ph_lo = 0; a.ph_hi = NPHASE;
    void* args[] = {&a};
    hipError_t e = hipLaunchCooperativeKernel((const void*)mega, dim3(grid), dim3(512), args, LDS_BYTES, stream);
    if (e != hipSuccess) fprintf(stderr, "cooperative launch failed: %s (grid %d)\n", hipGetErrorString(e), grid);
#endif
}
```

```cpp
#include <hip/hip_runtime.h>
#include <hip/hip_cooperative_groups.h>
#include <cstdio>
#include <cstdint>
namespace cg = cooperative_groups;
namespace pg8 {
#define PG8_LAS __attribute__((address_space(3)))
typedef unsigned short bf16_t;
typedef short bf16x8 __attribute__((ext_vector_type(8)));
typedef float f32x4 __attribute__((ext_vector_type(4)));
typedef unsigned u32x4 __attribute__((ext_vector_type(4)));
constexpr int BM = 256, BK = 64, HALF = 128, HTB = HALF * BK * 2  , STAGE_BYTES = 8 * HTB, NXCD = 8, WGM = 8;

__host__ __device__ __forceinline__ int lds_byte(int r, int c) { const int st = (r >> 4) * 2 + (c >> 5), rr = r & 15, cc = c & 31, ob = rr * 64 + cc * 2; return st * 1024 + (ob ^ (((ob >> 9) & 1) << 5)); }
__host__ __device__ __forceinline__ void stage_rc(int b, int& R, int& C) { const int st = b / 1024, sb = b % 1024, swz = sb ^ (((sb >> 9) & 1) << 5); R = (st >> 1) * 16 + swz / 64; C = (st & 1) * 32 + (swz % 64) / 2; }
__host__ __device__ __forceinline__ int perm32(int rho) { const int n = rho >> 4, i = rho & 15; return 8 * (i >> 2) + 4 * n + (i & 3); }

struct Unit { int pm, pn; };
struct Gemm { const bf16_t* A; const bf16_t* Bt; int M, N, K; };

struct StaticOrder {
    int nM, nN, nwg, G, c;
    __host__ __device__ void init(int M, int N, int G_, int c_) { nM = M / BM; nN = N / BM; nwg = nM * nN; G = G_; c = c_; }
    __host__ __device__ bool next(int i, Unit& u) const {
        const long L = (long)i * G + c; if (L >= nwg) return false;
        int wgid = (int)L; { const int q = nwg / NXCD, r = nwg % NXCD, xcd = wgid % NXCD, off = wgid / NXCD; wgid = (xcd < r ? xcd * (q + 1) : r * (q + 1) + (xcd - r) * q) + off; }
        const int nig = WGM * nN, gid = wgid / nig, fm = gid * WGM, gsz = (nM - fm) < WGM ? (nM - fm) : WGM;
        u.pm = fm + ((wgid % nig) % gsz); u.pn = (wgid % nig) / gsz; return true;
    }
    __device__ __forceinline__ void a_ready(const Unit&) const {}
    __device__ __forceinline__ void done(const Unit&) const {}
};
__device__ __forceinline__ unsigned cvt_pk_bf16(float lo, float hi) { unsigned r; asm volatile("v_cvt_pk_bf16_f32 %0, %1, %2" : "=v"(r) : "v"(lo), "v"(hi)); return r; }
typedef float f32x2 __attribute__((ext_vector_type(2)));
__device__ __forceinline__ float rstd_of(float ssq) { return __builtin_amdgcn_rsqf(ssq * (1.0f / 1024.0f) + 1e-6f); }
struct EpiSwiglu {
    static constexpr bool PERM = true, AFTER_DRAIN = false;
    bf16_t* H; const float* ssq; int ldh;
    __device__ __forceinline__ void operator()(const f32x4 (&acc)[2][2][4][2], const Unit& u, int wr, int wc, int fr, int fq) const {
        const int row0 = u.pm * BM + wr * 64 + fr, hcol = u.pn * HALF + wc * 32 + 8 * fq;
#pragma unroll
        for (int ai = 0; ai < 2; ++ai)
#pragma unroll
            for (int m = 0; m < 4; ++m) { const int row = row0 + ai * HALF + m * 16; const float rs = rstd_of(ssq[row]), nrl = -rs * 1.4426950408889634f, rs2 = rs * rs;
                float hv[8];
#pragma unroll
                for (int n = 0; n < 2; ++n)
#pragma unroll
                    for (int e = 0; e < 4; ++e) { const float g = acc[ai][0][m][n][e], up = acc[ai][1][m][n][e];
                        const float ex = __builtin_amdgcn_exp2f(g * nrl);
                        hv[n * 4 + e] = (g * up) * (rs2 * __builtin_amdgcn_rcpf(1.0f + ex)); }
                u32x4 w; w.x = cvt_pk_bf16(hv[0], hv[1]); w.y = cvt_pk_bf16(hv[2], hv[3]); w.z = cvt_pk_bf16(hv[4], hv[5]); w.w = cvt_pk_bf16(hv[6], hv[7]);
                *(u32x4*)(H + (size_t)row * ldh + hcol) = w; }
    }
};
struct EpiRes {
    static constexpr bool PERM = true, AFTER_DRAIN = false;
    const float* base; float* out; bf16_t* xa; const float* gain; float* ssq; float alpha;
    __device__ __forceinline__ void operator()(const f32x4 (&acc)[2][2][4][2], const Unit& u, int wr, int wc, int fr, int fq) const {
        const int row0 = u.pm * BM + wr * 64 + fr, col0 = u.pn * BM + wc * 32 + 8 * fq;
        f32x4 gv[2][2];
#pragma unroll
        for (int bj = 0; bj < 2; ++bj)
#pragma unroll
            for (int n = 0; n < 2; ++n) gv[bj][n] = *(const f32x4*)(gain + col0 + bj * HALF + 4 * n);
#pragma unroll
        for (int ai = 0; ai < 2; ++ai)
#pragma unroll
            for (int m = 0; m < 4; ++m) { const int row = row0 + ai * HALF + m * 16; float s = 0.f;
#pragma unroll
                for (int bj = 0; bj < 2; ++bj) { const size_t off = (size_t)row * 1024 + col0 + bj * HALF;
                    const f32x4 b0 = *(const f32x4*)(base + off), b1 = *(const f32x4*)(base + off + 4);
                    const f32x4 v0 = b0 + acc[ai][bj][m][0] * alpha, v1 = b1 + acc[ai][bj][m][1] * alpha;
                    *(f32x4*)(out + off) = v0; *(f32x4*)(out + off + 4) = v1;
                    s += (v0[0] * v0[0] + v0[1] * v0[1]) + (v0[2] * v0[2] + v0[3] * v0[3]) + (v1[0] * v1[0] + v1[1] * v1[1]) + (v1[2] * v1[2] + v1[3] * v1[3]);
                    const f32x4 a0 = v0 * gv[bj][0], a1 = v1 * gv[bj][1];
                    u32x4 w; w.x = cvt_pk_bf16(a0[0], a0[1]); w.y = cvt_pk_bf16(a0[2], a0[3]); w.z = cvt_pk_bf16(a1[0], a1[1]); w.w = cvt_pk_bf16(a1[2], a1[3]);
                    *(u32x4*)(xa + off) = w; }
                s += __shfl_xor(s, 16); s += __shfl_xor(s, 32);
                if (fq == 0) __hip_atomic_fetch_add(ssq + row, s, __ATOMIC_RELAXED, __HIP_MEMORY_SCOPE_AGENT); }
    }
};
struct EpiQKV {
    static constexpr bool PERM = true, AFTER_DRAIN = false;
    bf16_t* O; size_t stride; const float* ssq; float qscale; const float* rcos; const float* rsin;
    __device__ __forceinline__ void operator()(const f32x4 (&acc)[2][2][4][2], const Unit& u, int wr, int wc, int fr, int fq) const {
        const int t = u.pn >> 2, colt = (u.pn & 3) * BM;
        bf16_t* basep = O + (size_t)t * stride;
        const int row0 = u.pm * BM + wr * 64 + fr, col0 = colt + wc * 32 + 8 * fq;
        const float sc0 = (t == 0) ? qscale : 1.0f;
        const bool dorope = (rcos != nullptr) && (t < 2);
        const int pr0 = (wc & 1) * 16 + 4 * fq;
        if (t == 2) {
#pragma unroll
            for (int ai = 0; ai < 2; ++ai)
#pragma unroll
                for (int m = 0; m < 4; ++m) { const int row = row0 + ai * HALF + m * 16; const float sc = rstd_of(ssq[row]);
                    bf16_t* vp = basep + ((size_t)((row >> 11) * 1024 + col0)) * 2048 + (row & 2047);
#pragma unroll
                    for (int bj = 0; bj < 2; ++bj)
#pragma unroll
                        for (int n = 0; n < 2; ++n)
#pragma unroll
                            for (int e = 0; e < 4; ++e) { const unsigned w = cvt_pk_bf16(acc[ai][bj][m][n][e] * sc, 0.f); vp[(size_t)(bj * HALF + n * 4 + e) * 2048] = (bf16_t)w; } }
            return;
        }
#pragma unroll
        for (int ai = 0; ai < 2; ++ai)
#pragma unroll
            for (int m = 0; m < 4; ++m) { const int row = row0 + ai * HALF + m * 16; const float sc = rstd_of(ssq[row]) * sc0;
                f32x4 cs = (f32x4){1.f, 1.f, 1.f, 1.f}, sn = (f32x4){0.f, 0.f, 0.f, 0.f};
                if (dorope) { const int pos = row & 2047; cs = *(const f32x4*)(rcos + pos * 32 + pr0); sn = *(const f32x4*)(rsin + pos * 32 + pr0); }
#pragma unroll
                for (int bj = 0; bj < 2; ++bj) { const f32x4 v0 = acc[ai][bj][m][0] * sc, v1 = acc[ai][bj][m][1] * sc;
                    float o[8];
                    o[0] = v0[0] * cs[0] - v0[1] * sn[0]; o[1] = v0[1] * cs[0] + v0[0] * sn[0];
                    o[2] = v0[2] * cs[1] - v0[3] * sn[1]; o[3] = v0[3] * cs[1] + v0[2] * sn[1];
                    o[4] = v1[0] * cs[2] - v1[1] * sn[2]; o[5] = v1[1] * cs[2] + v1[0] * sn[2];
                    o[6] = v1[2] * cs[3] - v1[3] * sn[3]; o[7] = v1[3] * cs[3] + v1[2] * sn[3];
                    u32x4 w; w.x = cvt_pk_bf16(o[0], o[1]); w.y = cvt_pk_bf16(o[2], o[3]); w.z = cvt_pk_bf16(o[4], o[5]); w.w = cvt_pk_bf16(o[6], o[7]);
                    *(u32x4*)(basep + (size_t)row * 1024 + col0 + bj * HALF) = w; } }
    }
};

struct EpiNull {
    static constexpr bool PERM = true, AFTER_DRAIN = false;
    float* sink;
    __device__ __forceinline__ void operator()(const f32x4 (&acc)[2][2][4][2], const Unit& u, int wr, int wc, int fr, int fq) const {
        f32x4 s = (f32x4){0.f, 0.f, 0.f, 0.f};
#pragma unroll
        for (int ai = 0; ai < 2; ++ai)
#pragma unroll
            for (int bj = 0; bj < 2; ++bj)
#pragma unroll
                for (int m = 0; m < 4; ++m)
#pragma unroll
                    for (int n = 0; n < 2; ++n) s += acc[ai][bj][m][n];
        const float t = (s[0] + s[1]) + (s[2] + s[3]);
        if (t != t) sink[u.pm] = t;
    }
};
template <class Epi, class Sched, bool ALIGN_EPI = false, bool SP2 = false>
__device__ __forceinline__ void gemm_phase(PG8_LAS unsigned char* lds, const Gemm g, const Sched& S, const Epi& E) {
    int tid_ = threadIdx.x; asm volatile("" : "+v"(tid_));
    const int tid = tid_, wid = __builtin_amdgcn_readfirstlane(tid >> 6), lane = tid & 63, wr = wid >> 2, wc = wid & 3, fr = lane & 15, fq = lane >> 4;
    const int K = g.K, nt = K / BK;
    unsigned voffA[2], voffB[2];
#pragma unroll
    for (int i = 0; i < 2; ++i) { int R, C; stage_rc(tid * 16 + i * 8192, R, C); const int Rb = Epi::PERM ? ((R & ~31) + perm32(R & 31)) : R;
        voffA[i] = (unsigned)(R * K + C) * 2u; voffB[i] = (unsigned)(Rb * K + C) * 2u; }
    const size_t kstep = (size_t)(BK * 2);
    const size_t hstep = (size_t)HALF * K * 2;
    const size_t tstep = 2 * hstep;
    const unsigned ldsw = (unsigned)wid * 1024u;
    const int aoff = lds_byte(wr * 64 + fr, fq * 8), boff = lds_byte(wc * 32 + fr, fq * 8);
#define PG8_SA(b, h) (((b) * 2 + (h)) * HTB)
#define PG8_SB(b, h) ((4 + (b) * 2 + (h)) * HTB)
#define PG8_STAGE(bufoff, gbase, voff) do { _Pragma("unroll") for (int _i = 0; _i < 2; ++_i) \
        __builtin_amdgcn_global_load_lds((const unsigned*)((const char*)(gbase) + (voff)[_i]), (PG8_LAS unsigned*)(lds + (bufoff) + ldsw + _i * 8192), 16, 0, 0); } while (0)
#define PG8_LDA(dst, b, h) do { _Pragma("unroll") for (int m = 0; m < 4; ++m) _Pragma("unroll") for (int k = 0; k < 2; ++k) dst[m][k] = *(const PG8_LAS bf16x8*)(lds + PG8_SA(b, h) + aoff + m * 2048 + k * 1024); } while (0)
#define PG8_LDB(dst, b, h) do { _Pragma("unroll") for (int n = 0; n < 2; ++n) _Pragma("unroll") for (int k = 0; k < 2; ++k) dst[n][k] = *(const PG8_LAS bf16x8*)(lds + PG8_SB(b, h) + boff + n * 2048 + k * 1024); } while (0)
#define PG8_MMA(ai, bj, At, Bt) do { __builtin_amdgcn_s_setprio(1); _Pragma("unroll") for (int m = 0; m < 4; ++m) _Pragma("unroll") for (int n = 0; n < 2; ++n) _Pragma("unroll") for (int k = 0; k < 2; ++k) \
        acc[ai][bj][m][n] = __builtin_amdgcn_mfma_f32_16x16x32_bf16(Bt[n][k], At[m][k], acc[ai][bj][m][n], 0, 0, 0); __builtin_amdgcn_s_setprio(0); } while (0)
#define PG8_WAIT_V(n) asm volatile("s_waitcnt vmcnt(" #n ")" ::: "memory")
#define PG8_WAIT_L(n) asm volatile("s_waitcnt lgkmcnt(" #n ")" ::: "memory")
#define PG8_BAR __builtin_amdgcn_s_barrier()
#define PG8_SCHED __builtin_amdgcn_sched_barrier(0)
    Unit cur, nxt; int ui = 0;
    if (!S.next(0, cur)) return;
    f32x4 acc[2][2][4][2];
#pragma unroll
    for (int a = 0; a < 2; ++a)
#pragma unroll
        for (int b = 0; b < 2; ++b)
#pragma unroll
            for (int m = 0; m < 4; ++m)
#pragma unroll
                for (int n = 0; n < 2; ++n) acc[a][b][m][n] = (f32x4){0.f, 0.f, 0.f, 0.f};
    bf16x8 At[4][2], B0[2][2], B1[2][2];
    const char* cA = (const char*)g.A + (size_t)cur.pm * tstep; const char* cB = (const char*)g.Bt + (size_t)cur.pn * tstep;
    S.a_ready(cur);
    if constexpr (SP2) {
        PG8_STAGE(PG8_SB(0, 0), cB, voffB); PG8_STAGE(PG8_SB(0, 1), cB + hstep, voffB); PG8_STAGE(PG8_SA(0, 0), cA, voffA); PG8_STAGE(PG8_SA(0, 1), cA + hstep, voffA);
        if (wr == 1) PG8_BAR;
        PG8_WAIT_V(2); PG8_BAR;
        PG8_STAGE(PG8_SB(1, 0), cB + kstep, voffB); PG8_STAGE(PG8_SA(1, 0), cA + kstep, voffA); PG8_STAGE(PG8_SB(1, 1), cB + hstep + kstep, voffB);
        PG8_WAIT_V(6); PG8_BAR;
    } else {
        PG8_STAGE(PG8_SB(0, 0), cB, voffB); PG8_STAGE(PG8_SA(0, 0), cA, voffA); PG8_STAGE(PG8_SB(0, 1), cB + hstep, voffB); PG8_STAGE(PG8_SA(0, 1), cA + hstep, voffA);
        if (wr == 1) PG8_BAR;
        PG8_WAIT_V(4); PG8_BAR;
        PG8_STAGE(PG8_SB(1, 0), cB + kstep, voffB); PG8_STAGE(PG8_SA(1, 0), cA + kstep, voffA); PG8_STAGE(PG8_SB(1, 1), cB + hstep + kstep, voffB);
        PG8_WAIT_V(6); PG8_BAR;
    }
    for (;;) {
        const bool has_next = S.next(ui + 1, nxt);
        const char* nA = has_next ? (const char*)g.A + (size_t)nxt.pm * tstep : cA; const char* nB = has_next ? (const char*)g.Bt + (size_t)nxt.pn * tstep : cB;
        for (int t = 0; t < nt; t += 2) {
            const bool last = (t == nt - 2);
            const char* a1 = cA + (size_t)(t + 1) * kstep;
            const char* a2 = last ? nA : cA + (size_t)(t + 2) * kstep; const char* b2 = last ? nB : cB + (size_t)(t + 2) * kstep;
            const char* a3 = a2 + kstep; const char* b3 = b2 + kstep;
            if (last && has_next) S.a_ready(nxt);
            if constexpr (SP2) {
            PG8_LDB(B0, 0, 0); PG8_LDB(B1, 0, 1); PG8_SCHED; PG8_LDA(At, 0, 0); PG8_STAGE(PG8_SA(1, 1), a1 + hstep, voffA);
            PG8_WAIT_V(8); PG8_WAIT_L(0); PG8_BAR; PG8_MMA(0, 0, At, B0); PG8_MMA(0, 1, At, B1); PG8_BAR; PG8_SCHED;
            PG8_LDA(At, 0, 1); PG8_STAGE(PG8_SB(0, 0), b2, voffB); PG8_STAGE(PG8_SB(0, 1), b2 + hstep, voffB); PG8_STAGE(PG8_SA(0, 0), a2, voffA);
            PG8_WAIT_V(8); PG8_WAIT_L(0); PG8_BAR; PG8_MMA(1, 0, At, B0); PG8_MMA(1, 1, At, B1); PG8_BAR; PG8_SCHED;
            PG8_LDB(B0, 1, 0); PG8_LDB(B1, 1, 1); PG8_SCHED; PG8_LDA(At, 1, 0); PG8_STAGE(PG8_SA(0, 1), a2 + hstep, voffA);
            PG8_WAIT_V(8); PG8_WAIT_L(0); PG8_BAR; PG8_MMA(0, 0, At, B0); PG8_MMA(0, 1, At, B1); PG8_BAR; PG8_SCHED;
            PG8_LDA(At, 1, 1); PG8_STAGE(PG8_SB(1, 0), b3, voffB); PG8_STAGE(PG8_SB(1, 1), b3 + hstep, voffB); PG8_STAGE(PG8_SA(1, 0), a3, voffA);
            PG8_WAIT_V(8); PG8_WAIT_L(0); PG8_BAR; PG8_MMA(1, 0, At, B0); PG8_MMA(1, 1, At, B1); PG8_BAR; PG8_SCHED;
            } else {
            PG8_LDB(B0, 0, 0); PG8_SCHED; PG8_LDA(At, 0, 0); PG8_STAGE(PG8_SA(1, 1), a1 + hstep, voffA);
            PG8_WAIT_L(8); PG8_BAR; PG8_WAIT_L(0); PG8_MMA(0, 0, At, B0); PG8_BAR; PG8_SCHED;
            PG8_LDB(B1, 0, 1); PG8_STAGE(PG8_SB(0, 0), b2, voffB);
            PG8_BAR; PG8_WAIT_L(0); PG8_MMA(0, 1, At, B1); PG8_BAR;
            PG8_LDA(At, 0, 1); PG8_STAGE(PG8_SA(0, 0), a2, voffA);
            PG8_BAR; PG8_WAIT_L(0); PG8_MMA(1, 0, At, B0); PG8_BAR; PG8_SCHED;
            PG8_STAGE(PG8_SB(0, 1), b2 + hstep, voffB);
            PG8_WAIT_V(6); PG8_BAR; PG8_MMA(1, 1, At, B1); PG8_BAR;
            PG8_LDB(B0, 1, 0); PG8_SCHED; PG8_LDA(At, 1, 0); PG8_STAGE(PG8_SA(0, 1), a2 + hstep, voffA);
            PG8_WAIT_L(8); PG8_BAR; PG8_WAIT_L(0); PG8_MMA(0, 0, At, B0); PG8_BAR; PG8_SCHED;
            PG8_LDB(B1, 1, 1); PG8_STAGE(PG8_SB(1, 0), b3, voffB);
            PG8_BAR; PG8_WAIT_L(0); PG8_MMA(0, 1, At, B1); PG8_BAR;
            PG8_LDA(At, 1, 1); PG8_STAGE(PG8_SA(1, 0), a3, voffA);
            PG8_BAR; PG8_WAIT_L(0); PG8_MMA(1, 0, At, B0); PG8_BAR; PG8_SCHED;
            PG8_STAGE(PG8_SB(1, 1), b3 + hstep, voffB);
            PG8_WAIT_V(6); PG8_BAR; PG8_MMA(1, 1, At, B1); PG8_BAR;
            }
        }
        if constexpr (ALIGN_EPI) { if (wr == 0) PG8_BAR; }
        if constexpr (!Epi::AFTER_DRAIN) { E(acc, cur, wr, wc, fr, fq); S.done(cur); }
        if (!has_next) break;
#pragma unroll
        for (int a = 0; a < 2; ++a)
#pragma unroll
            for (int b = 0; b < 2; ++b)
#pragma unroll
                for (int m = 0; m < 4; ++m)
#pragma unroll
                    for (int n = 0; n < 2; ++n) acc[a][b][m][n] = (f32x4){0.f, 0.f, 0.f, 0.f};
        cur = nxt; cA = nA; cB = nB; ++ui;
        if constexpr (ALIGN_EPI) { if (wr == 1) PG8_BAR; }
    }
    PG8_WAIT_V(0);
    if constexpr (!ALIGN_EPI) { if (wr == 0) PG8_BAR; }
    PG8_BAR;
    if constexpr (Epi::AFTER_DRAIN) { E.fused(acc, cur, wr, wc, fr, fq, lds, wid, lane); S.done(cur); }
#undef PG8_SA
#undef PG8_SB
#undef PG8_STAGE
#undef PG8_LDA
#undef PG8_LDB
#undef PG8_MMA
#undef PG8_WAIT_V
#undef PG8_WAIT_L
#undef PG8_BAR
#undef PG8_SCHED
}
}
constexpr int SEQ = 2048, NB = 8, DM = 1024, M = NB * SEQ, FF = 2816, NUP = 2 * FF, NQKV = 3 * DM;
constexpr float QSCALE = 0.125f * 1.4426950408889634f;
constexpr float LAMBDA_INIT = 0.35550906f;
constexpr size_t MiB = 1u << 20;
constexpr size_t WS_SSQ = 256 * 1024;
constexpr size_t WS_ROPE = 1 * MiB;
constexpr size_t WS_WIN = 2 * MiB;
constexpr size_t WS_WOUT = 46 * MiB;
constexpr size_t WS_WQKV = 68 * MiB;
constexpr size_t WS_WO = 80 * MiB;
constexpr size_t WS_XA = 84 * MiB;
constexpr size_t WS_H = 116 * MiB;
constexpr size_t WS_Q = 116 * MiB, WS_K = 148 * MiB, WS_V = 180 * MiB;
constexpr size_t WS_O = 212 * MiB;
constexpr size_t WS_T = 244 * MiB;
constexpr size_t WS_END = 308 * MiB;
constexpr int LDS_BYTES = 147456;
constexpr int NPHASE = 16;

#define GAS __attribute__((address_space(1)))
#define LAS __attribute__((address_space(3)))
typedef unsigned short bf16;
typedef unsigned v4u __attribute__((ext_vector_type(4)));
typedef float f32x4 __attribute__((ext_vector_type(4)));
__device__ __forceinline__ unsigned f2bf(float f) { unsigned u = __builtin_bit_cast(unsigned, f); return (u + 0x7fffu + ((u >> 16) & 1u)) >> 16; }
__device__ __forceinline__ unsigned pk2(float lo, float hi) { return f2bf(lo) | (f2bf(hi) << 16); }
__device__ __forceinline__ float bflo(unsigned u) { return __uint_as_float(u << 16); }
__device__ __forceinline__ float bfhi(unsigned u) { return __uint_as_float(u & 0xffff0000u); }
__device__ __forceinline__ int tid_opaque() { int t = threadIdx.x; asm volatile("" : "+v"(t)); return t; }
__device__ __forceinline__ int bid_opaque() { int t = blockIdx.x; asm volatile("" : "+s"(t)); return t; }
__device__ __forceinline__ float wave_sum(float v) {
#pragma unroll
    for (int o = 1; o < 64; o <<= 1) v += __shfl_xor(v, o);
    return v;
}

struct Args { const float* x; const float* ng; const float* fg; const float* w_in; const float* w_out; const float* sb_qkv; const float* sb_o;
              const float* df_qkv; const float* df_o; const float* df_lam; const float* df_sub; float* out; unsigned char* ws; int ph_lo, ph_hi; };

__device__ __forceinline__ int dst_row(int mode, int n) {
    if (mode == 1) { const int isu = n >= FF ? 1 : 0, j = n - isu * FF; return 256 * (j >> 7) + 128 * isu + (j & 127); }
    if (mode == 2) { if (n < 2048) { const int d = n & 63; return (n & ~63) + (d < 32 ? 2 * d : 2 * (d - 32) + 1); } return n; }
    return n;
}
__device__ __forceinline__ void transpose_item(const float* W, int K, int N, bf16* WT, int mode, LAS float* scr, int item, int lane) {
    const int nblk = N / 32, kb = item / nblk, nb = item % nblk, k0 = 64 * kb, n0 = 32 * nb;
#pragma unroll 8
    for (int i = 0; i < 32; ++i) { const int kk = 2 * i + (lane >> 5); scr[kk * 33 + (lane & 31)] = W[(size_t)(k0 + kk) * N + n0 + (lane & 31)]; }
    asm volatile("s_waitcnt lgkmcnt(0)" ::: "memory");
    const int c = lane & 7;
#pragma unroll
    for (int j = 0; j < 4; ++j) { const int n = (lane >> 3) + 8 * j; const LAS float* s = scr + (8 * c) * 33 + n;
        v4u o; o.x = pk2(s[0 * 33], s[1 * 33]); o.y = pk2(s[2 * 33], s[3 * 33]); o.z = pk2(s[4 * 33], s[5 * 33]); o.w = pk2(s[6 * 33], s[7 * 33]);
        *(v4u*)(WT + (size_t)dst_row(mode, n0 + n) * K + k0 + 8 * c) = o; }
    asm volatile("s_waitcnt lgkmcnt(0)" ::: "memory");
}
__device__ __forceinline__ void prologue(const Args& a, LAS unsigned char* lds) {
    const int tid = tid_opaque(), lane = tid & 63, wave = tid >> 6; const int bid = bid_opaque();
    LAS float* scr = (LAS float*)(lds + wave * 16384);
    const int gw = bid * 8 + wave, NGW = gridDim.x * 8;
    unsigned char* ws = a.ws;
    for (int mi = 0; mi < 12; ++mi) {
        const float* W; bf16* WT; int K, N, mode;
        if (mi < 4) { W = a.w_in + (size_t)mi * DM * NUP; WT = (bf16*)(ws + WS_WIN) + (size_t)mi * NUP * DM; K = DM; N = NUP; mode = 1; }
        else if (mi < 8) { W = a.w_out + (size_t)(mi - 4) * FF * DM; WT = (bf16*)(ws + WS_WOUT) + (size_t)(mi - 4) * DM * FF; K = FF; N = DM; mode = 0; }
        else if (mi == 8) { W = a.sb_qkv; WT = (bf16*)(ws + WS_WQKV); K = DM; N = NQKV; mode = 0; }
        else if (mi == 9) { W = a.df_qkv; WT = (bf16*)(ws + WS_WQKV) + (size_t)NQKV * DM; K = DM; N = NQKV; mode = 2; }
        else if (mi == 10) { W = a.sb_o; WT = (bf16*)(ws + WS_WO); K = DM; N = DM; mode = 0; }
        else { W = a.df_o; WT = (bf16*)(ws + WS_WO) + (size_t)DM * DM; K = DM; N = DM; mode = 0; }
        const int nit = (K / 64) * (N / 32);
        for (int it = gw; it < nit; it += NGW) transpose_item(W, K, N, WT, mode, scr, it, lane);
    }
    float* ssq = (float*)(ws + WS_SSQ); bf16* XA = (bf16*)(ws + WS_XA);
    f32x4 gv[4];
#pragma unroll
    for (int j = 0; j < 4; ++j) gv[j] = *((const f32x4*)a.ng + lane + 64 * j);
    for (int m = gw; m < M; m += NGW) {
        const f32x4* xr = (const f32x4*)(a.x + (size_t)m * DM) + lane; f32x4 v[4]; float s = 0.f;
#pragma unroll
        for (int j = 0; j < 4; ++j) { v[j] = xr[64 * j]; s += (v[j][0] * v[j][0] + v[j][1] * v[j][1]) + (v[j][2] * v[j][2] + v[j][3] * v[j][3]); }
        s = wave_sum(s);
        if (lane == 0) ssq[m] = s;
        unsigned long long* o8 = (unsigned long long*)(XA + (size_t)m * DM) + lane;
#pragma unroll
        for (int j = 0; j < 4; ++j) { const f32x4 t = v[j] * gv[j]; o8[64 * j] = (unsigned long long)pk2(t[0], t[1]) | ((unsigned long long)pk2(t[2], t[3]) << 32); }
    }
    const int gt = bid * 512 + tid, NGT = gridDim.x * 512;
    for (int i = gt; i < 6 * M; i += NGT) ssq[M + i] = 0.f;
    float* rc = (float*)(ws + WS_ROPE); float* rsn = rc + 2048 * 32;
    for (int i = gt; i < 2048 * 32; i += NGT) { const int pos = i >> 5, fi = i & 31;
        const float inv = __builtin_amdgcn_exp2f(-(float)fi * (13.287712379549449f / 32.0f));
        const float ang = (float)pos * inv;
        const double rev = (double)ang * 0.15915494309189535; const float fr = (float)(rev - rint(rev));
        rc[i] = __builtin_amdgcn_cosf(fr); rsn[i] = __builtin_amdgcn_sinf(fr); }
}
__device__ __forceinline__ void final_norm(const Args& a) {
    const int tid = tid_opaque(), lane = tid & 63, wave = tid >> 6; const int bid = bid_opaque();
    const int gw = bid * 8 + wave, NGW = gridDim.x * 8;
    const float* ssq = (const float*)(a.ws + WS_SSQ) + 6 * M;
    f32x4 gv[4];
#pragma unroll
    for (int j = 0; j < 4; ++j) gv[j] = *((const f32x4*)a.fg + lane + 64 * j);
    for (int m = gw; m < M; m += NGW) { const float rs = pg8::rstd_of(ssq[m]); f32x4* xr = (f32x4*)(a.out + (size_t)m * DM) + lane;
#pragma unroll
        for (int j = 0; j < 4; ++j) xr[64 * j] = xr[64 * j] * rs * gv[j]; }
}

__device__ __forceinline__ void sb_attn_naive(const bf16* Q, const bf16* K, const bf16* V, bf16* O) {
    const int tidn = tid_opaque();
    for (int it = bid_opaque(); it < 512; it += gridDim.x) {
        const int bh = it & 127, qb = 3 - (it >> 7), b = bh >> 4, h = bh & 15;
        const int t = qb * 512 + tidn;
        const uint4* qp = (const uint4*)(Q + ((size_t)(b * SEQ + t)) * DM + h * 64);
        float q[64], o[64];
#pragma unroll
        for (int j = 0; j < 8; ++j) { const uint4 w = qp[j]; q[8 * j] = bflo(w.x); q[8 * j + 1] = bfhi(w.x); q[8 * j + 2] = bflo(w.y); q[8 * j + 3] = bfhi(w.y); q[8 * j + 4] = bflo(w.z); q[8 * j + 5] = bfhi(w.z); q[8 * j + 6] = bflo(w.w); q[8 * j + 7] = bfhi(w.w); }
#pragma unroll
        for (int d = 0; d < 64; ++d) o[d] = 0.f;
        float R = 0.f;
        for (int s = qb * 512 + 511; s >= 0; --s) {
            const uint4* kp = (const uint4*)(K + ((size_t)(b * SEQ + s)) * DM + h * 64);
            float z = 0.f;
#pragma unroll
            for (int j = 0; j < 8; ++j) { const uint4 w = kp[j]; z += q[8 * j] * bflo(w.x) + q[8 * j + 1] * bfhi(w.x) + q[8 * j + 2] * bflo(w.y) + q[8 * j + 3] * bfhi(w.y) + q[8 * j + 4] * bflo(w.z) + q[8 * j + 5] * bfhi(w.z) + q[8 * j + 6] * bflo(w.w) + q[8 * j + 7] * bfhi(w.w); }
            if (s < t) {
                const float sp = fmaxf(z, 0.f) + __builtin_amdgcn_logf(1.0f + __builtin_amdgcn_exp2f(-fabsf(z)));
                const float aw = __builtin_amdgcn_exp2f((z - sp) + R);
                R -= sp;
                const bf16* vp = V + ((size_t)(b * 1024 + h * 64)) * SEQ + s;
#pragma unroll
                for (int d = 0; d < 64; ++d) o[d] += aw * bflo((unsigned)vp[(size_t)d * SEQ]);
            }
        }
        uint4* op = (uint4*)(O + ((size_t)(b * SEQ + t)) * DM + h * 64);
#pragma unroll
        for (int j = 0; j < 8; ++j) { uint4 w; w.x = pk2(o[8 * j], o[8 * j + 1]); w.y = pk2(o[8 * j + 2], o[8 * j + 3]); w.z = pk2(o[8 * j + 4], o[8 * j + 5]); w.w = pk2(o[8 * j + 6], o[8 * j + 7]); op[j] = w; }
    }
}
__device__ __forceinline__ float diff_lambda(const float* lp) {
    float s1 = 0.f, s2 = 0.f;
    for (int i = 0; i < 64; ++i) { s1 += lp[i] * lp[64 + i]; s2 += lp[128 + i] * lp[192 + i]; }
    return expf(s1) - expf(s2) + LAMBDA_INIT;
}
__device__ __forceinline__ void diff_attn_naive(const bf16* Q, const bf16* K, const bf16* V, bf16* O, float* T, const float* lamp, const float* subg) {
    const float lam = diff_lambda(lamp);
    const int tidn = tid_opaque();
    for (int it = bid_opaque(); it < 256; it += gridDim.x) {
        const int bh = it & 63, qb = 3 - (it >> 6), b = bh >> 3, h = bh & 7;
        const int t = qb * 512 + tidn, kend = ((t >> 6) + 1) << 6;
        float* Tr = T + ((size_t)(b * SEQ + t)) * DM + h * 128;
        for (int vh = 0; vh < 2; ++vh)
            for (int mp = 0; mp < 2; ++mp) {
                const uint4* qp = (const uint4*)(Q + ((size_t)(b * SEQ + t)) * DM + (h * 2 + mp) * 64);
                float q[64], o[64];
#pragma unroll
                for (int j = 0; j < 8; ++j) { const uint4 w = qp[j]; q[8 * j] = bflo(w.x); q[8 * j + 1] = bfhi(w.x); q[8 * j + 2] = bflo(w.y); q[8 * j + 3] = bfhi(w.y); q[8 * j + 4] = bflo(w.z); q[8 * j + 5] = bfhi(w.z); q[8 * j + 6] = bflo(w.w); q[8 * j + 7] = bfhi(w.w); }
#pragma unroll
                for (int d = 0; d < 64; ++d) o[d] = 0.f;
                float mx = -1e30f, l = 0.f;
                for (int s = 0; s < qb * 512 + 512; ++s) {
                    const uint4* kp = (const uint4*)(K + ((size_t)(b * SEQ + s)) * DM + (h * 2 + mp) * 64);
                    float z = 0.f;
#pragma unroll
                    for (int j = 0; j < 8; ++j) { const uint4 w = kp[j]; z += q[8 * j] * bflo(w.x) + q[8 * j + 1] * bfhi(w.x) + q[8 * j + 2] * bflo(w.y) + q[8 * j + 3] * bfhi(w.y) + q[8 * j + 4] * bflo(w.z) + q[8 * j + 5] * bfhi(w.z) + q[8 * j + 6] * bflo(w.w) + q[8 * j + 7] * bfhi(w.w); }
                    if (s < kend) {
                        const float mn = fmaxf(mx, z), f = __builtin_amdgcn_exp2f(mx - mn), p = __builtin_amdgcn_exp2f(z - mn);
                        mx = mn; l = l * f + p;
                        const bf16* vp = V + ((size_t)(b * 1024 + h * 128 + vh * 64)) * SEQ + s;
#pragma unroll
                        for (int d = 0; d < 64; ++d) o[d] = o[d] * f + p * bflo((unsigned)vp[(size_t)d * SEQ]);
                    }
                }
                const float il = 1.0f / l;
                if (mp == 0) {
#pragma unroll
                    for (int d = 0; d < 64; d += 4) *(f32x4*)(Tr + vh * 64 + d) = (f32x4){o[d] * il, o[d + 1] * il, o[d + 2] * il, o[d + 3] * il};
                } else {
#pragma unroll
                    for (int d = 0; d < 64; d += 4) { const f32x4 p1 = *(const f32x4*)(Tr + vh * 64 + d);
                        *(f32x4*)(Tr + vh * 64 + d) = (f32x4){p1[0] - lam * o[d] * il, p1[1] - lam * o[d + 1] * il, p1[2] - lam * o[d + 2] * il, p1[3] - lam * o[d + 3] * il}; }
                }
            }
        float ss = 0.f;
        for (int d = 0; d < 128; d += 4) { const f32x4 v = *(const f32x4*)(Tr + d); ss += (v[0] * v[0] + v[1] * v[1]) + (v[2] * v[2] + v[3] * v[3]); }
        const float rs = (1.0f / sqrtf(ss * (1.0f / 128.0f) + 1e-6f)) * (1.0f - LAMBDA_INIT);
        bf16* Or = O + ((size_t)(b * SEQ + t)) * DM + h * 128;
        for (int d = 0; d < 128; d += 4) { const f32x4 v = *(const f32x4*)(Tr + d); const f32x4 g = *(const f32x4*)(subg + d);
            uint2 w; w.x = pk2(v[0] * rs * g[0], v[1] * rs * g[1]); w.y = pk2(v[2] * rs * g[2], v[3] * rs * g[3]); *(uint2*)(Or + d) = w; }
    }
}
typedef short a_bf16x8 __attribute__((ext_vector_type(8)));
typedef short a_s16x4 __attribute__((ext_vector_type(4)));
typedef _Float16 a_f16x8 __attribute__((ext_vector_type(8)));
typedef float a_f32x16 __attribute__((ext_vector_type(16)));
#define A_LDS_BARRIER() asm volatile("s_waitcnt lgkmcnt(0)\n\ts_barrier" ::: "memory")
#define A_SBAR() __builtin_amdgcn_sched_barrier(0)
__device__ __forceinline__ float a_max(float x, float y) { float r; asm("v_max_f32_e32 %0, %1, %2" : "=v"(r) : "v"(x), "v"(y)); return r; }
__device__ __forceinline__ float a_max3(float x, float y, float z) { float r; asm("v_max3_f32 %0, %1, %2, %3" : "=v"(r) : "v"(x), "v"(y), "v"(z)); return r; }
__device__ __forceinline__ float a_pair_max(float m) { auto rr = __builtin_amdgcn_permlane32_swap(__float_as_uint(m), __float_as_uint(m), false, false); return a_max(__uint_as_float(rr[0]), __uint_as_float(rr[1])); }
__device__ __forceinline__ float a_pair_sum(float m) { auto rr = __builtin_amdgcn_permlane32_swap(__float_as_uint(m), __float_as_uint(m), false, false); return __uint_as_float(rr[0]) + __uint_as_float(rr[1]); }
__device__ __forceinline__ float a_lo_bcast(float m) { auto rr = __builtin_amdgcn_permlane32_swap(__float_as_uint(m), __float_as_uint(m), false, false); return __uint_as_float(rr[0]); }
__device__ __forceinline__ void a_stage_vt(LAS unsigned char* vb, int cs, int row, int sch, v4u v) { typedef unsigned u2 __attribute__((ext_vector_type(2)));
    LAS unsigned char* p = vb + (sch >> 1) * 2 * cs + row * 16 + 8 * (sch & 1); *(LAS u2*)(p) = (u2){v.x, v.y}; *(LAS u2*)(p + cs) = (u2){v.z, v.w}; }
constexpr int SB_CS = 1152, DF_CSV = 2176;
__device__ __forceinline__ int crow(int r, int hi) { return (r & 3) + 8 * (r >> 2) + 4 * hi; }
__device__ __forceinline__ unsigned a_cvtpk(float lo, float hi) { typedef float f2 __attribute__((ext_vector_type(2))); typedef __bf16 b2 __attribute__((ext_vector_type(2))); f2 v = {lo, hi}; b2 b = __builtin_convertvector(v, b2); return __builtin_bit_cast(unsigned, b); }
#define A_PACK_BF16(P0, P1, PW) do { \
    PW[0] = __builtin_bit_cast(a_bf16x8, (v4u){a_cvtpk(P0[0], P0[1]), a_cvtpk(P0[2], P0[3]), a_cvtpk(P0[4], P0[5]), a_cvtpk(P0[6], P0[7])}); \
    PW[1] = __builtin_bit_cast(a_bf16x8, (v4u){a_cvtpk(P0[8], P0[9]), a_cvtpk(P0[10], P0[11]), a_cvtpk(P0[12], P0[13]), a_cvtpk(P0[14], P0[15])}); \
    PW[2] = __builtin_bit_cast(a_bf16x8, (v4u){a_cvtpk(P1[0], P1[1]), a_cvtpk(P1[2], P1[3]), a_cvtpk(P1[4], P1[5]), a_cvtpk(P1[6], P1[7])}); \
    PW[3] = __builtin_bit_cast(a_bf16x8, (v4u){a_cvtpk(P1[8], P1[9]), a_cvtpk(P1[10], P1[11]), a_cvtpk(P1[12], P1[13]), a_cvtpk(P1[14], P1[15])}); } while (0)

__device__ __forceinline__ void sb_attn(const bf16* Q, const bf16* K, const bf16* VT, bf16* O, LAS unsigned char* lds) {
    const int tid = tid_opaque(), lane = tid & 63, r32 = lane & 31, hi = lane >> 5, wid = __builtin_amdgcn_readfirstlane(tid >> 6);
    const int c = bid_opaque(), G = gridDim.x;
    a_f16x8 TA0, TA1, ONES;
#pragma unroll
    for (int e = 0; e < 8; ++e) { const int kin = 4 * hi + (e & 3) + 8 * (e >> 2); TA0[e] = (kin > r32) ? (_Float16)1.0f : (_Float16)0.0f; TA1[e] = (16 + kin > r32) ? (_Float16)1.0f : (_Float16)0.0f; ONES[e] = (_Float16)1.0f; }
    for (int u = c; u < 1024; u += G) {
        const int cc = u & 255, ui = u >> 8, bh = cc >> 1, sg = cc & 1;
        const int qb = (ui == 0) ? 7 - sg : (ui == 1) ? sg : (ui == 2) ? 5 - sg : 2 + sg;
        const int b = bh >> 4, h = bh & 15;
        const int q0 = qb * 256 + wid * 32, td = q0 >> 6, Tmax = qb * 4 + 3, qloc = (q0 & 63) + r32;
        const bf16* Qw = Q + ((size_t)(b * SEQ + q0 + r32)) * DM + h * 64 + hi * 8;
        a_bf16x8 qr[4];
#pragma unroll
        for (int d0 = 0; d0 < 4; ++d0) qr[d0] = *(const a_bf16x8*)(Qw + d0 * 16);
        a_f32x16 ot[2]; ot[0] = (a_f32x16){}; ot[1] = (a_f32x16){};
        float R = 0.f;
        const int srow = tid >> 3, sch = tid & 7, sdst = sch * SB_CS + srow * 16;
        const bf16* kg = K + ((size_t)(b * SEQ + srow)) * DM + h * 64 + sch * 8;
        const bf16* vg = VT + ((size_t)(b * 1024 + h * 64 + srow)) * SEQ + sch * 8;
        v4u kreg = *(const v4u*)(kg + (size_t)Tmax * 64 * DM), vreg = *(const v4u*)(vg + Tmax * 64);
        LAS int* dflag = (LAS int*)(lds + 40960) + (ui & 1) * 8;
        if (lane == 0) dflag[wid] = -1;
        bool fin = false;
        for (int t = Tmax; t >= 0; --t) {
            LAS unsigned char* kb = lds + ((Tmax - t) & 1) * (2 * 8 * SB_CS); LAS unsigned char* vb = kb + 8 * SB_CS;
            *(LAS v4u*)(kb + sdst) = kreg; a_stage_vt(vb, SB_CS, srow, sch, vreg);
            if (t > 0) { kreg = *(const v4u*)(kg + (size_t)(t - 1) * 64 * DM); vreg = *(const v4u*)(vg + (t - 1) * 64); }
            A_LDS_BARRIER();
            { const int dv = dflag[lane & 7]; if (__all(dv > t)) break; }
            if (t <= td && !fin) {
                a_bf16x8 kf[8];
#pragma unroll
                for (int d0 = 0; d0 < 4; ++d0) { kf[2 * d0] = *(const LAS a_bf16x8*)(kb + (2 * d0 + hi) * SB_CS + r32 * 16); kf[2 * d0 + 1] = *(const LAS a_bf16x8*)(kb + (2 * d0 + hi) * SB_CS + 512 + r32 * 16); }
                a_f32x16 p0 = (a_f32x16){}, p1 = (a_f32x16){};
#pragma unroll
                for (int d0 = 0; d0 < 4; ++d0) { p0 = __builtin_amdgcn_mfma_f32_32x32x16_bf16(kf[2 * d0], qr[d0], p0, 0, 0, 0); p1 = __builtin_amdgcn_mfma_f32_32x32x16_bf16(kf[2 * d0 + 1], qr[d0], p1, 0, 0, 0); }
                a_bf16x8 vf[8];
#pragma unroll
                for (int blk = 0; blk < 2; ++blk)
#pragma unroll
                    for (int j = 0; j < 4; ++j) vf[blk * 4 + j] = *(const LAS a_bf16x8*)(vb + (2 * j + hi) * SB_CS + (32 * blk + r32) * 16);
                A_SBAR();
                const bool diag = (t == td);
                float lv0[16], lv1[16];
#pragma unroll
                for (int r = 0; r < 16; ++r) {
                    { const float z = p0[r], uu = __builtin_amdgcn_logf(1.0f + __builtin_amdgcn_exp2f(-fabsf(z))); float sp = a_max(z, 0.f) + uu, ls = z - sp;
                      if (diag && crow(r, hi) >= qloc) { sp = 0.f; ls = -__builtin_inff(); } p0[r] = ls; lv0[r] = -sp; }
                    { const float z = p1[r], uu = __builtin_amdgcn_logf(1.0f + __builtin_amdgcn_exp2f(-fabsf(z))); float sp = a_max(z, 0.f) + uu, ls = z - sp;
                      if (diag && 32 + crow(r, hi) >= qloc) { sp = 0.f; ls = -__builtin_inff(); } p1[r] = ls; lv1[r] = -sp; }
                }
                a_f16x8 lw[4];
#pragma unroll
                for (int e = 0; e < 8; ++e) { lw[0][e] = (_Float16)lv0[e]; lw[1][e] = (_Float16)lv0[8 + e]; lw[2][e] = (_Float16)lv1[e]; lw[3][e] = (_Float16)lv1[8 + e]; }
                a_f32x16 s0, s1;
#pragma unroll
                for (int r = 0; r < 16; ++r) { s0[r] = R; s1[r] = R; }
                s0 = __builtin_amdgcn_mfma_f32_32x32x16_f16(TA0, lw[0], s0, 0, 0, 0); s1 = __builtin_amdgcn_mfma_f32_32x32x16_f16(TA0, lw[2], s1, 0, 0, 0);
                s0 = __builtin_amdgcn_mfma_f32_32x32x16_f16(TA1, lw[1], s0, 0, 0, 0); s1 = __builtin_amdgcn_mfma_f32_32x32x16_f16(TA1, lw[3], s1, 0, 0, 0);
                s0 = __builtin_amdgcn_mfma_f32_32x32x16_f16(ONES, lw[2], s0, 0, 0, 0); s0 = __builtin_amdgcn_mfma_f32_32x32x16_f16(ONES, lw[3], s0, 0, 0, 0);
                R = a_lo_bcast(s0[0] + lv0[0]);
#pragma unroll
                for (int r = 0; r < 16; ++r) { p0[r] = __builtin_amdgcn_exp2f(p0[r] + s0[r]); p1[r] = __builtin_amdgcn_exp2f(p1[r] + s1[r]); }
                a_bf16x8 pw[4]; A_PACK_BF16(p0, p1, pw);
                A_SBAR();
#pragma unroll
                for (int j = 0; j < 4; ++j)
#pragma unroll
                    for (int blk = 0; blk < 2; ++blk) ot[blk] = __builtin_amdgcn_mfma_f32_32x32x16_bf16(vf[blk * 4 + j], pw[j], ot[blk], 0, 0, 0);
                if (__all(R < -150.0f)) { fin = true; if (lane == 0) dflag[wid] = t; }
            }
        }
        bf16* Ow = O + ((size_t)(b * SEQ + q0 + r32)) * DM + h * 64 + 4 * hi;
#pragma unroll
        for (int blk = 0; blk < 2; ++blk)
#pragma unroll
            for (int g = 0; g < 4; ++g) { uint2 w; w.x = a_cvtpk(ot[blk][4 * g], ot[blk][4 * g + 1]); w.y = a_cvtpk(ot[blk][4 * g + 2], ot[blk][4 * g + 3]); *(uint2*)(Ow + 32 * blk + 8 * g) = w; }
    }
}

__device__ __forceinline__ void diff_attn(const bf16* Q, const bf16* K, const bf16* VT, bf16* O, const float* lamp, const float* subg, LAS unsigned char* lds) {
    const int tid = tid_opaque(), lane = tid & 63, r32 = lane & 31, hi = lane >> 5, wid = __builtin_amdgcn_readfirstlane(tid >> 6), mp = wid >> 2, w4 = wid & 3;
    const int c = bid_opaque(), G = gridDim.x;
    const float lam = diff_lambda(lamp);
    constexpr int DF_STAGE = 16 * SB_CS + 8 * DF_CSV;
    LAS float* ex = (LAS float*)(lds + 2 * DF_STAGE);
    for (int u = c; u < 1024; u += G) {
        const int cc = u & 255, ui = u >> 8, bh = cc >> 2, sg = cc & 3;
        const int qb = (ui == 0) ? 15 - sg : (ui == 1) ? 8 + sg : (ui == 2) ? 7 - sg : sg;
        const int b = bh >> 3, h = bh & 7;
        const int q0 = qb * 128 + w4 * 32, tdw = q0 >> 6, Tmax = qb * 2 + 1;
        const bf16* Qw = Q + ((size_t)(b * SEQ + q0 + r32)) * DM + (h * 2 + mp) * 64 + hi * 8;
        a_bf16x8 qr[4];
#pragma unroll
        for (int d0 = 0; d0 < 4; ++d0) qr[d0] = *(const a_bf16x8*)(Qw + d0 * 16);
        a_f32x16 ot[4];
#pragma unroll
        for (int i = 0; i < 4; ++i) ot[i] = (a_f32x16){};
        float mx = -1e30f, l = 0.f;
        const int srow = tid >> 3, sch = tid & 7;
        const bf16* kg = K + ((size_t)(b * SEQ + srow)) * DM + h * 128 + sch * 8;
        const bf16* vg = VT + ((size_t)(b * 1024 + h * 128 + srow)) * SEQ + sch * 8;
        v4u k1r = *(const v4u*)(kg), k2r = *(const v4u*)(kg + 64), v1r = *(const v4u*)(vg), v2r = *(const v4u*)(vg + 64 * SEQ);
        for (int t = 0; t <= Tmax; ++t) {
            LAS unsigned char* base = lds + (t & 1) * DF_STAGE;
            *(LAS v4u*)(base + sch * SB_CS + srow * 16) = k1r; *(LAS v4u*)(base + 8 * SB_CS + sch * SB_CS + srow * 16) = k2r;
            a_stage_vt(base + 16 * SB_CS, DF_CSV, srow, sch, v1r); a_stage_vt(base + 16 * SB_CS, DF_CSV, srow + 64, sch, v2r);
            if (t < Tmax) { const size_t ko = (size_t)(t + 1) * 64 * DM; const int vo = (t + 1) * 64;
                k1r = *(const v4u*)(kg + ko); k2r = *(const v4u*)(kg + ko + 64); v1r = *(const v4u*)(vg + vo); v2r = *(const v4u*)(vg + vo + 64 * SEQ); }
            A_LDS_BARRIER();
            if (t <= tdw) {
                LAS unsigned char* kb = base + mp * 8 * SB_CS; LAS unsigned char* vb = base + 16 * SB_CS;
                a_bf16x8 kf[8];
#pragma unroll
                for (int d0 = 0; d0 < 4; ++d0) { kf[2 * d0] = *(const LAS a_bf16x8*)(kb + (2 * d0 + hi) * SB_CS + r32 * 16); kf[2 * d0 + 1] = *(const LAS a_bf16x8*)(kb + (2 * d0 + hi) * SB_CS + 512 + r32 * 16); }
                a_f32x16 p0 = (a_f32x16){}, p1 = (a_f32x16){};
#pragma unroll
                for (int d0 = 0; d0 < 4; ++d0) { p0 = __builtin_amdgcn_mfma_f32_32x32x16_bf16(kf[2 * d0], qr[d0], p0, 0, 0, 0); p1 = __builtin_amdgcn_mfma_f32_32x32x16_bf16(kf[2 * d0 + 1], qr[d0], p1, 0, 0, 0); }
                a_bf16x8 vf[16];
#pragma unroll
                for (int blk = 0; blk < 4; ++blk)
#pragma unroll
                    for (int j = 0; j < 4; ++j) vf[blk * 4 + j] = *(const LAS a_bf16x8*)(vb + (2 * j + hi) * DF_CSV + (32 * blk + r32) * 16);
                A_SBAR();
                float rm = a_max3(p0[0], p1[0], p0[1]);
#pragma unroll
                for (int r = 1; r < 15; ++r) rm = a_max3(rm, p1[r], p0[r + 1]);
                rm = a_pair_max(a_max(rm, p1[15]));
                if (__any(rm > mx)) { const float mn = a_max(mx, rm), f = __builtin_amdgcn_exp2f(mx - mn); mx = mn; l *= f;
#pragma unroll
                    for (int i = 0; i < 4; ++i) ot[i] = ot[i] * f; }
                float ps = 0.f;
#pragma unroll
                for (int r = 0; r < 16; ++r) { p0[r] = __builtin_amdgcn_exp2f(p0[r] - mx); p1[r] = __builtin_amdgcn_exp2f(p1[r] - mx); ps += p0[r] + p1[r]; }
                l += ps;
                a_bf16x8 pw[4]; A_PACK_BF16(p0, p1, pw);
                A_SBAR();
#pragma unroll
                for (int j = 0; j < 4; ++j)
#pragma unroll
                    for (int blk = 0; blk < 4; ++blk) ot[blk] = __builtin_amdgcn_mfma_f32_32x32x16_bf16(vf[blk * 4 + j], pw[j], ot[blk], 0, 0, 0);
            }
        }
        const float il = 1.0f / a_pair_sum(l);
        if (mp == 1) {
#pragma unroll
            for (int blk = 0; blk < 4; ++blk)
#pragma unroll
                for (int r = 0; r < 16; ++r) ex[((w4 * 4 + blk) * 16 + r) * 64 + lane] = ot[blk][r] * il;
        }
        __syncthreads();
        if (mp == 0) {
            float ss = 0.f;
#pragma unroll
            for (int blk = 0; blk < 4; ++blk)
#pragma unroll
                for (int r = 0; r < 16; ++r) { const float o = ot[blk][r] * il - lam * ex[((w4 * 4 + blk) * 16 + r) * 64 + lane]; ot[blk][r] = o; ss += o * o; }
            ss = a_pair_sum(ss);
            const float rs = (1.0f / sqrtf(ss * (1.0f / 128.0f) + 1e-6f)) * (1.0f - LAMBDA_INIT);
            bf16* Ow = O + ((size_t)(b * SEQ + q0 + r32)) * DM + h * 128 + 4 * hi;
#pragma unroll
            for (int blk = 0; blk < 4; ++blk)
#pragma unroll
                for (int g = 0; g < 4; ++g) { const f32x4 gg = *(const f32x4*)(subg + 32 * blk + 8 * g + 4 * hi);
                    uint2 w; w.x = a_cvtpk(ot[blk][4 * g] * rs * gg[0], ot[blk][4 * g + 1] * rs * gg[1]); w.y = a_cvtpk(ot[blk][4 * g + 2] * rs * gg[2], ot[blk][4 * g + 3] * rs * gg[3]);
                    *(uint2*)(Ow + 32 * blk + 8 * g) = w; }
        }
    }
}
#define XB_TMO      128
#define XB_XCNT(j)  (256  + 64 * (j))
#define XB_XSUB(j)  (1280 + 64 * (j))
#define XB_XGEN(j)  (2304 + 64 * (j))
#define XB_TOP      3328
#define XB_TOPGEN   3392
#define XCD_BAR_WORDS 3456
#define XB_SPIN_CAP (1u << 18)

__device__ __forceinline__ unsigned xb_ld(unsigned* p)              { return __hip_atomic_load(p, __ATOMIC_RELAXED, __HIP_MEMORY_SCOPE_AGENT); }
__device__ __forceinline__ unsigned xb_add(unsigned* p, unsigned v) { return __hip_atomic_fetch_add(p, v, __ATOMIC_RELAXED, __HIP_MEMORY_SCOPE_AGENT); }
__device__ __forceinline__ unsigned xb_xcc_id() { return (unsigned)__builtin_amdgcn_s_getreg((3 << 11) | 20) & 0xFu; }
#define XB_SPIN(cond, bar) do { unsigned _sp = 0; while (cond) { __builtin_amdgcn_s_sleep(1); \
    if ((++_sp & 255u) == 0u) { if (xb_ld(&(bar)[XB_TMO])) break; if (_sp > XB_SPIN_CAP) { atomicAdd(&(bar)[XB_TMO], 1u); break; } } } } while (0)

struct XcdBarrier {
    unsigned* bar; unsigned x;
    volatile LAS unsigned* st;
};

__device__ __forceinline__ XcdBarrier xcd_barrier_post(unsigned* bar, volatile LAS unsigned* st) {
    XcdBarrier b; b.bar = bar; b.x = xb_xcc_id(); b.st = st;
    if (threadIdx.x == 0) (void)xb_add(&bar[XB_XCNT(b.x)], 1u);
    return b;
}
__device__ __forceinline__ void xcd_barrier_complete(unsigned* bar, unsigned x, unsigned& nloc, unsigned& nx) {
    const unsigned G = gridDim.x * gridDim.y * gridDim.z;
    unsigned sum, cnt, mine, sp = 0u;
    for (;;) {
        sum = 0u; cnt = 0u; mine = 0u;
#pragma unroll
        for (unsigned j = 0; j < 16; ++j) { const unsigned c = xb_ld(&bar[XB_XCNT(j)]); sum += c; cnt += (c > 0u) ? 1u : 0u; mine = (j == x) ? c : mine; }
        if (sum == G) break;
        __builtin_amdgcn_s_sleep(1);
        if ((++sp & 255u) == 0u) { if (xb_ld(&bar[XB_TMO])) break; if (sp > XB_SPIN_CAP) { atomicAdd(&bar[XB_TMO], 1u); break; } }
    }
    nloc = mine > 0u ? mine : 1u; nx = cnt > 0u ? cnt : 1u;
}

__device__ __forceinline__ void xcd_barrier(const XcdBarrier& b) {
    asm volatile("s_waitcnt vmcnt(0)" ::: "memory");
    __syncthreads();
    if (threadIdx.x == 0) {
        unsigned* bar = b.bar;
        __builtin_amdgcn_s_waitcnt(0);
        unsigned nloc = b.st[0], nx = b.st[1];
        if (nloc == 0u) { xcd_barrier_complete(bar, b.x, nloc, nx); b.st[0] = nloc; b.st[1] = nx; }
        const unsigned old = xb_add(&bar[XB_XSUB(b.x)], 1u);
        const unsigned gen = old / nloc;
        if (old + 1u == (gen + 1u) * nloc) {
            __builtin_amdgcn_fence(__ATOMIC_RELEASE, "agent");
            asm volatile("s_waitcnt vmcnt(0)" ::: "memory");
            const unsigned og = xb_add(&bar[XB_TOP], 1u);
            const unsigned tg = og / nx;
            if (og + 1u == (tg + 1u) * nx) xb_add(&bar[XB_TOPGEN], 1u);
            else XB_SPIN(xb_ld(&bar[XB_TOPGEN]) == tg, bar);
            __builtin_amdgcn_fence(__ATOMIC_ACQUIRE, "agent");
            xb_add(&bar[XB_XGEN(b.x)], 1u);
            asm volatile("s_waitcnt vmcnt(0)" ::: "memory");
        } else {
            XB_SPIN(xb_ld(&bar[XB_XGEN(b.x)]) == gen, bar);
            __builtin_amdgcn_fence(__ATOMIC_ACQUIRE, "agent");
            asm volatile("s_waitcnt vmcnt(0)" ::: "memory");
        }
    }
    __syncthreads();
}
#ifndef MK_MULTI
#define MK_MULTI 0
#endif
__global__ void __launch_bounds__(512, 2) mega(Args a_in) {
    extern __shared__ __attribute__((aligned(16))) unsigned char lds_raw[];
    LAS unsigned char* lds = (LAS unsigned char*)lds_raw;
    cg::grid_group grid = cg::this_grid();
    const int ph_lo = a_in.ph_lo, ph_hi = a_in.ph_hi;
    volatile LAS unsigned* MISC = (volatile LAS unsigned*)(lds + LDS_BYTES - 128);
    if (threadIdx.x < 32) MISC[threadIdx.x] = 0u;
    __syncthreads();
    XcdBarrier bar = xcd_barrier_post((unsigned*)a_in.ws, MISC + 8);
    for (int p = ph_lo; p < ph_hi; ++p) {
#if defined(MK_REREAD)

    unsigned long long apv = (unsigned long long)__builtin_amdgcn_kernarg_segment_ptr();
    unsigned aplo = (unsigned)apv, aphi = (unsigned)(apv >> 32); asm volatile("" : "+s"(aplo), "+s"(aphi));
    aplo = __builtin_amdgcn_readfirstlane(aplo); aphi = __builtin_amdgcn_readfirstlane(aphi);
    const __attribute__((address_space(4))) unsigned char* ap = (const __attribute__((address_space(4))) unsigned char*)(((unsigned long long)aphi << 32) | aplo);
    Args a; __builtin_memcpy(&a, ap, sizeof(Args));
#else
    const Args a = a_in;
#endif
    unsigned char* ws = a.ws;
    float* ssq = (float*)(ws + WS_SSQ);
    bf16* XA = (bf16*)(ws + WS_XA); bf16* H = (bf16*)(ws + WS_H); bf16* Q = (bf16*)(ws + WS_Q); bf16* Kb = (bf16*)(ws + WS_K); bf16* Vb = (bf16*)(ws + WS_V); bf16* O = (bf16*)(ws + WS_O);
    const bf16* Win = (const bf16*)(ws + WS_WIN); const bf16* Wout = (const bf16*)(ws + WS_WOUT); const bf16* Wqkv = (const bf16*)(ws + WS_WQKV); const bf16* Wo = (const bf16*)(ws + WS_WO);
    const int G = gridDim.x, c = bid_opaque();
    {
        if (p == 0) {
#ifndef NO_PRO
 prologue(a, lds);
#if defined(PROBE_PRO2)
 __syncthreads(); prologue(a, lds);
#endif
#endif
 }
        else if (p == NPHASE - 1) final_norm(a);
        else {
            const int L = (p - 1) / 7, s = (p - 1) % 7;
            if (s == 0 || s == 5) {
                const int ab = (s == 5) ? 1 : 0;
                pg8::Gemm g{XA, Win + (size_t)(L * 2 + ab) * NUP * DM, M, NUP, DM}; pg8::StaticOrder S; S.init(M, NUP, G, c);
                pg8::EpiSwiglu E{H, ssq + (size_t)(3 * L + 2 * ab) * M, FF};

#ifndef NO_UP
 pg8::gemm_phase<pg8::EpiSwiglu, pg8::StaticOrder, true, true>(lds, g, S, E);
#if defined(PROBE_UP2)
 __syncthreads(); pg8::gemm_phase<pg8::EpiSwiglu, pg8::StaticOrder, true, true>(lds, g, S, E);
#endif
#if defined(PROBE_UPNULL)
 { __syncthreads(); pg8::EpiNull EN{(float*)(ws + WS_T)}; pg8::gemm_phase<pg8::EpiNull, pg8::StaticOrder, true, true>(lds, g, S, EN); }
#endif
#endif

            } else if (s == 1 || s == 4 || s == 6) {
                const bf16* A; const bf16* Bt; int K; float alpha; int nn; const float* gain;
                if (s == 4) { A = O; Bt = Wo + (size_t)L * DM * DM; K = DM; alpha = 1.0f; nn = 3 * L + 2; gain = a.ng + (size_t)(3 * L + 2) * DM; }
                else if (s == 1) { A = H; Bt = Wout + (size_t)(L * 2) * DM * FF; K = FF; alpha = 0.5f; nn = 3 * L + 1; gain = a.ng + (size_t)(3 * L + 1) * DM; }
                else { A = H; Bt = Wout + (size_t)(L * 2 + 1) * DM * FF; K = FF; alpha = 0.5f; nn = 3 * L + 3; gain = (L == 1) ? a.fg : a.ng + (size_t)(3 * L + 3) * DM; }
                pg8::Gemm g{A, Bt, M, DM, K}; pg8::StaticOrder S; S.init(M, DM, G, c);
                pg8::EpiRes E{(p == 2) ? a.x : a.out, a.out, XA, gain, ssq + (size_t)nn * M, alpha};

#ifndef NO_RES
 pg8::gemm_phase<pg8::EpiRes, pg8::StaticOrder, true, true>(lds, g, S, E);
#endif

            } else if (s == 2) {
                pg8::Gemm g{XA, Wqkv + (size_t)L * NQKV * DM, M, NQKV, DM}; pg8::StaticOrder S; S.init(M, NQKV, G, c);
                const float* rc = (const float*)(ws + WS_ROPE);
                pg8::EpiQKV E{Q, (size_t)(WS_K - WS_Q) / 2, ssq + (size_t)(3 * L + 1) * M, QSCALE, L == 1 ? rc : nullptr, rc + 2048 * 32};

#ifndef NO_QKV
 pg8::gemm_phase<pg8::EpiQKV, pg8::StaticOrder, true, true>(lds, g, S, E);
#if defined(PROBE_QKV2)
 __syncthreads(); pg8::gemm_phase<pg8::EpiQKV, pg8::StaticOrder, true, true>(lds, g, S, E);
#endif
#endif

            } else {

#if defined(SB_NAIVE)
                if (L == 0) sb_attn_naive(Q, Kb, Vb, O);
#else
                if (L == 0) { sb_attn(Q, Kb, Vb, O, lds);
#if defined(PROBE_SB2)
 __syncthreads(); sb_attn(Q, Kb, Vb, O, lds);
#endif
 }
#endif
#if defined(DF_NAIVE)
                if (L == 1) diff_attn_naive(Q, Kb, Vb, O, (float*)(ws + WS_T), a.df_lam, a.df_sub);
#else
                if (L == 1) { diff_attn(Q, Kb, Vb, O, a.df_lam, a.df_sub, lds);
#if defined(PROBE_DF2)
 __syncthreads(); diff_attn(Q, Kb, Vb, O, a.df_lam, a.df_sub, lds);
#endif
 }
#endif

            }
        }
        if (p + 1 < ph_hi) {
#if defined(MK_ALL_CG)
            grid.sync();
#else
            if (ph_hi > NPHASE) grid.sync(); else xcd_barrier(bar);
#endif
        }
    }
    }
}

extern "C" void kernel_launch(void* const* d_in, const int* in_sizes, int n_in, void* d_out, int out_size, void* d_ws, size_t ws_size, hipStream_t stream) {
    static int grid = 0;
    if (grid == 0) {
        if (n_in != 11 || in_sizes[0] != M * DM || out_size != M * DM || ws_size < WS_END) { fprintf(stderr, "kernel_launch: unexpected shapes (n_in %d, in0 %d, out %d, ws %zu)\n", n_in, n_in > 0 ? in_sizes[0] : -1, out_size, ws_size); grid = -1; return; }
        int dev = 0, cus = 0, per_cu = 0;
        if (hipGetDevice(&dev) != hipSuccess || hipDeviceGetAttribute(&cus, hipDeviceAttributeMultiprocessorCount, dev) != hipSuccess) { grid = -1; return; }
        if (hipFuncSetAttribute((const void*)mega, hipFuncAttributeMaxDynamicSharedMemorySize, LDS_BYTES) != hipSuccess) { fprintf(stderr, "kernel_launch: hipFuncSetAttribute failed\n"); grid = -1; return; }
        if (hipOccupancyMaxActiveBlocksPerMultiprocessor(&per_cu, (const void*)mega, 512, LDS_BYTES) != hipSuccess || per_cu < 1) { fprintf(stderr, "kernel_launch: occupancy query gave %d\n", per_cu); per_cu = 1; }
        (void)hipGetLastError();
        grid = cus * (per_cu > 1 ? 1 : per_cu);
    }
    if (grid < 0) return;
    if (hipMemsetAsync(d_ws, 0, 16384, stream) != hipSuccess) { fprintf(stderr, "kernel_launch: memset failed\n"); return; }
    Args a{};
    a.x = (const float*)d_in[0]; a.ng = (const float*)d_in[1]; a.fg = (const float*)d_in[2]; a.w_in = (const float*)d_in[3]; a.w_out = (const float*)d_in[4];
    a.sb_qkv = (const float*)d_in[5]; a.sb_o = (const float*)d_in[6]; a.df_qkv = (const float*)d_in[7]; a.df_o = (const float*)d_in[8]; a.df_lam = (const float*)d_in[9]; a.df_sub = (const float*)d_in[10];
    a.out = (float*)d_out; a.ws = (unsigned char*)d_ws;
#if MK_MULTI
    for (int p = 0; p < NPHASE; ++p) { a.ph_lo = p; a.ph_hi = p + 1; hipLaunchKernelGGL(mega, dim3(grid), dim3(512), LDS_BYTES, stream, a); }
#else
    a.ph_lo = 0; a.ph_hi = NPHASE;
    void* args[] = {&a};
    hipError_t e = hipLaunchCooperativeKernel((const void*)mega, dim3(grid), dim3(512), args, LDS_BYTES, stream);
    if (e != hipSuccess) fprintf(stderr, "cooperative launch failed: %s (grid %d)\n", hipGetErrorString(e), grid);
#endif
}
```
